# Optimizing an MI355X kernel written in HIP

```python
import math
import jax, jax.numpy as jnp
from jax import lax
import numpy as np


D_MODEL = 1024
BATCH = 16
SEQ = 2048
DEPTH = 2

CTX_LEN = 256
GRID_W = 64
EPS = 1e-6
ROPE_BASE = 10000.0
RET_HEADS = 4
RET_DK = 64
RET_DV = 64
RET_CHUNK = 128
RET_QK = RET_HEADS * RET_DK
RET_WIDTH = RET_HEADS * RET_DV
DIFF_HEADS = 4
DIFF_DK = 64
DIFF_DV = 2 * DIFF_DK
DIFF_QK = DIFF_HEADS * 2 * DIFF_DK
DIFF_WIDTH = DIFF_HEADS * DIFF_DV
Q_BLOCK = 128
CONV_CH = D_MODEL // 4
CONV_WIDTH = 31
CONV_PAD = (CONV_WIDTH - 1) // 2
MIX_WIDTH = RET_WIDTH + DIFF_WIDTH + CONV_CH
IN_WIDTH = 2 * RET_QK + 2 * RET_WIDTH + 2 * DIFF_QK + DIFF_WIDTH + 2 * CONV_CH
D_FF = 4 * D_MODEL
N_MOD = 6

kernel_name = 'hybrid_retention_diffattn_conformer_dit'


def rmsnorm(x, w):
    xf = x.astype(jnp.float32)
    y = xf * lax.rsqrt(jnp.mean(xf * xf, axis=-1, keepdims=True) + EPS)
    return (y * w).astype(x.dtype)


def layernorm(x, w, b):
    xf = x.astype(jnp.float32)
    mu = jnp.mean(xf, axis=-1, keepdims=True)
    var = jnp.mean(jnp.square(xf - mu), axis=-1, keepdims=True)
    return (xf - mu) * lax.rsqrt(var + EPS) * w + b


def modulate(h, shift, scale):
    return h * (1.0 + scale) + shift


def split_proj(p):
    sizes = (RET_QK, RET_QK, RET_WIDTH, RET_WIDTH, DIFF_QK, DIFF_QK, DIFF_WIDTH, CONV_CH, CONV_CH)
    out, start = [], 0
    for s in sizes:
        out.append(p[..., start:start + s])
        start += s
    return out


def rope_angles(pos, dim):
    inv = ROPE_BASE ** (-jnp.arange(0, dim, 2, dtype=jnp.float32) / dim)
    ang = pos.astype(jnp.float32)[:, None] * inv[None, :]
    return jnp.cos(ang), jnp.sin(ang)


def apply_rope(x, cos, sin):
    half = x.shape[-1] // 2
    shape = (cos.shape[0],) + (1,) * (x.ndim - 3) + (half,)
    cos = cos.reshape(shape)
    sin = sin.reshape(shape)
    x1, x2 = x[..., :half], x[..., half:]
    return jnp.concatenate([x1 * cos - x2 * sin, x2 * cos + x1 * sin], axis=-1).astype(x.dtype)


def axial_rope(x, rows, cols):
    h = x.shape[-1] // 2
    cr, sr = rope_angles(rows, h)
    cc, sc = rope_angles(cols, h)
    return jnp.concatenate([apply_rope(x[..., :h], cr, sr), apply_rope(x[..., h:], cc, sc)], axis=-1)


def retention_chunkwise(q, k, v, log_gamma, s0):
    b, h, l, dk = q.shape
    dv = v.shape[-1]
    n = l // RET_CHUNK
    qc = q.reshape(b, h, n, RET_CHUNK, dk)
    kc = k.reshape(b, h, n, RET_CHUNK, dk)
    vc = v.reshape(b, h, n, RET_CHUNK, dv)
    idx = jnp.arange(RET_CHUNK, dtype=jnp.float32)
    lg = log_gamma[:, None]
    rel = idx[:, None] - idx[None, :]
    intra = jnp.where(rel >= 0, jnp.exp(lg[:, :, None] * jnp.maximum(rel, 0.0)), 0.0)
    scores = jnp.einsum('bhncd,bhnsd->bhncs', qc, kc) * intra[:, None]
    o_intra = jnp.einsum('bhncs,bhnse->bhnce', scores, vc)
    q_decay = jnp.exp(lg * (idx + 1.0))
    k_decay = jnp.exp(lg * (RET_CHUNK - 1.0 - idx))
    chunk_decay = jnp.exp(log_gamma * RET_CHUNK)[None, :, None, None]
    kv = jnp.einsum('bhncd,hc,bhnce->nbhde', kc, k_decay, vc)

    def step(s, kv_n):
        return chunk_decay * s + kv_n, s

    _, s_prev = lax.scan(step, s0, kv)
    o_cross = jnp.einsum('bhncd,hc,nbhde->bhnce', qc, q_decay, s_prev)
    return (o_intra + o_cross).reshape(b, h, l, dv)


def retention_final_state(k, v, log_gamma):
    l = k.shape[2]
    w = jnp.exp(log_gamma[:, None] * (l - 1.0 - jnp.arange(l, dtype=jnp.float32)))
    return jnp.einsum('bhld,hl,bhle->bhde', k, w, v)


def retention_output(o, g, gn_w):
    b, h, l, dv = o.shape
    t = layernorm(o.transpose(0, 2, 1, 3), gn_w.reshape(h, dv), 0.0)
    return t.reshape(b, l, h * dv) * jax.nn.silu(g)


def diff_attend(q, k, v, lam):
    b, lq, h, _, dk = q.shape
    nb = lq // Q_BLOCK
    qb = jnp.moveaxis(q.reshape(b, nb, Q_BLOCK, h, 2, dk), 1, 0)
    scale = dk ** -0.5

    def block(qblk):
        s = jnp.einsum('bqhmd,bkhmd->bhmqk', qblk, k).astype(jnp.float32) * scale
        p = jax.nn.softmax(s, axis=-1)
        a = p[:, :, 0] - lam * p[:, :, 1]
        return jnp.einsum('bhqk,bkhe->bqhe', a.astype(v.dtype), v)

    o = lax.map(block, qb)
    return jnp.moveaxis(o, 0, 1).reshape(b, lq, h, v.shape[-1])


def diff_output(o, gn_w, lam_init):
    b, l, h, dv = o.shape
    return (rmsnorm(o, gn_w.reshape(h, dv)) * (1.0 - lam_init)).reshape(b, l, h * dv)


def conformer_conv(val, gate, conv_w, conv_b, ln_w, ln_b):
    u = val * jax.nn.sigmoid(gate)
    y = lax.conv_general_dilated(u, conv_w[:, None, :].astype(u.dtype), window_strides=(1,),
                                 padding=[(CONV_PAD, CONV_PAD)],
                                 dimension_numbers=('NWC', 'WIO', 'NWC'),
                                 feature_group_count=CONV_CH) + conv_b
    return jax.nn.silu(layernorm(y, ln_w, ln_b)).astype(val.dtype)


def sq_relu_mlp(h, w1, w2):
    return jnp.square(jax.nn.relu(h @ w1)) @ w2


def hybrid_mixer(hx, hc, w_in, ret_log_decay, ret_gn_w, diff_lam, lam_init, diff_gn_w,
                 conv_w, conv_b, conv_ln_w, conv_ln_b, w_out, rows, cols, need_ctx_out):
    b, l, _ = hx.shape
    lc = hc.shape[1]
    rq_x, rk_x, rv_x, rg_x, dq_x, dk_x, dv_x, cv_x, cg_x = split_proj(hx @ w_in)
    rq_c, rk_c, rv_c, rg_c, dq_c, dk_c, dv_c, cv_c, cg_c = split_proj(hc @ w_in)
    flip = lambda t: jnp.flip(t, axis=2)

    cos1, sin1 = rope_angles(jnp.arange(l), RET_DK)
    rk_scale = RET_DK ** -0.5
    q_lat = apply_rope(rq_x.reshape(b, l, RET_HEADS, RET_DK), cos1, sin1).transpose(0, 2, 1, 3)
    k_lat = (apply_rope(rk_x.reshape(b, l, RET_HEADS, RET_DK), cos1, sin1) * rk_scale).transpose(0, 2, 1, 3)
    v_lat = rv_x.reshape(b, l, RET_HEADS, RET_DV).transpose(0, 2, 1, 3)
    k_ctx = (rk_c.reshape(b, lc, RET_HEADS, RET_DK) * rk_scale).transpose(0, 2, 1, 3)
    v_ctx = rv_c.reshape(b, lc, RET_HEADS, RET_DV).transpose(0, 2, 1, 3)
    log_g = -jnp.exp(ret_log_decay.astype(jnp.float32))
    s_fwd = retention_final_state(k_ctx, v_ctx, log_g[0])
    s_bwd = retention_final_state(flip(k_ctx), flip(v_ctx), log_g[1])
    o_f = retention_chunkwise(q_lat, k_lat, v_lat, log_g[0], s_fwd)
    o_b = retention_chunkwise(flip(q_lat), flip(k_lat), flip(v_lat), log_g[1], s_bwd)
    ret_x = retention_output(o_f + flip(o_b), rg_x, ret_gn_w)

    dq_lat = axial_rope(dq_x.reshape(b, l, DIFF_HEADS, 2, DIFF_DK), rows, cols)
    dk_lat = axial_rope(dk_x.reshape(b, l, DIFF_HEADS, 2, DIFF_DK), rows, cols)
    dv_lat = dv_x.reshape(b, l, DIFF_HEADS, DIFF_DV)
    dk_ctx = dk_c.reshape(b, lc, DIFF_HEADS, 2, DIFF_DK)
    dv_ctx = dv_c.reshape(b, lc, DIFF_HEADS, DIFF_DV)
    lam = (jnp.exp(jnp.sum(diff_lam[0] * diff_lam[1])) - jnp.exp(jnp.sum(diff_lam[2] * diff_lam[3]))
           + lam_init).astype(jnp.float32)
    k_all = jnp.concatenate([dk_lat, dk_ctx], axis=1)
    v_all = jnp.concatenate([dv_lat, dv_ctx], axis=1)
    diff_x = diff_output(diff_attend(dq_lat, k_all, v_all, lam), diff_gn_w, lam_init)

    conv_x = conformer_conv(cv_x, cg_x, conv_w, conv_b, conv_ln_w, conv_ln_b)

    y_x = (jnp.concatenate([ret_x, diff_x, conv_x], axis=-1) @ w_out).astype(hx.dtype)
    if not need_ctx_out:
        return y_x, None

    q_ctx = rq_c.reshape(b, lc, RET_HEADS, RET_DK).transpose(0, 2, 1, 3)
    s0 = jnp.zeros((b, RET_HEADS, RET_DK, RET_DV), jnp.float32)
    oc_f = retention_chunkwise(q_ctx, k_ctx, v_ctx, log_g[0], s0)
    oc_b = retention_chunkwise(flip(q_ctx), flip(k_ctx), flip(v_ctx), log_g[1], s0)
    ret_c = retention_output(oc_f + flip(oc_b), rg_c, ret_gn_w)
    dq_ctx = dq_c.reshape(b, lc, DIFF_HEADS, 2, DIFF_DK)
    diff_c = diff_output(diff_attend(dq_ctx, dk_ctx, dv_ctx, lam), diff_gn_w, lam_init)
    conv_c = conformer_conv(cv_c, cg_c, conv_w, conv_b, conv_ln_w, conv_ln_b)
    y_c = (jnp.concatenate([ret_c, diff_c, conv_c], axis=-1) @ w_out).astype(hc.dtype)
    return y_x, y_c


def setup_inputs(seed: int = 0) -> dict:
    key = jax.random.key(seed)
    ks = jax.random.split(key, 24)
    nrm = lambda k, shape, s: jax.random.normal(k, shape, jnp.float32) * s
    gain = lambda k, shape: 1.0 + 0.1 * jax.random.normal(k, shape, jnp.float32)
    base_decay = jnp.log(-jnp.log(1.0 - 2.0 ** (-5.0 - jnp.arange(RET_HEADS, dtype=jnp.float32))))
    return {
        'x': nrm(ks[0], (BATCH, SEQ, D_MODEL), 1.0),
        'c': nrm(ks[1], (BATCH, D_MODEL), 1.0),
        'ctx': nrm(ks[2], (BATCH, CTX_LEN, D_MODEL), 1.0),
        'c_ctx': nrm(ks[3], (D_MODEL,), 1.0),
        'norm1_w': gain(ks[4], (DEPTH, D_MODEL)),
        'norm2_w': gain(ks[5], (DEPTH, D_MODEL)),
        'ada_w': nrm(ks[6], (DEPTH, D_MODEL, N_MOD * D_MODEL), 0.5 * D_MODEL ** -0.5),
        'ada_b': nrm(ks[7], (DEPTH, N_MOD * D_MODEL), 0.01),
        'w_in': nrm(ks[8], (DEPTH, D_MODEL, IN_WIDTH), D_MODEL ** -0.5),
        'ret_log_decay': base_decay[None, None, :] + nrm(ks[9], (DEPTH, 2, RET_HEADS), 0.05),
        'ret_gn_w': gain(ks[10], (DEPTH, RET_WIDTH)),
        'diff_lam': nrm(ks[11], (DEPTH, 4, DIFF_DK), 0.1),
        'diff_gn_w': gain(ks[12], (DEPTH, DIFF_WIDTH)),
        'conv_w': nrm(ks[13], (DEPTH, CONV_WIDTH, CONV_CH), CONV_WIDTH ** -0.5),
        'conv_b': nrm(ks[14], (DEPTH, CONV_CH), 0.01),
        'conv_ln_w': gain(ks[15], (DEPTH, CONV_CH)),
        'conv_ln_b': nrm(ks[16], (DEPTH, CONV_CH), 0.01),
        'w_out': nrm(ks[17], (DEPTH, MIX_WIDTH, D_MODEL), MIX_WIDTH ** -0.5),
        'mlp_w1': nrm(ks[18], (DEPTH, D_MODEL, D_FF), D_MODEL ** -0.5),
        'mlp_w2': nrm(ks[19], (DEPTH, D_FF, D_MODEL), D_FF ** -0.5),
        'final_norm_w': gain(ks[20], (D_MODEL,)),
    }


def reference(x, c, ctx, c_ctx, norm1_w, norm2_w, ada_w, ada_b, w_in, ret_log_decay, ret_gn_w,
              diff_lam, diff_gn_w, conv_w, conv_b, conv_ln_w, conv_ln_b, w_out, mlp_w1, mlp_w2,
              final_norm_w):
    l = x.shape[1]
    rows_n = l // GRID_W
    rows = jnp.repeat(jnp.arange(rows_n), GRID_W)
    cols = jnp.tile(jnp.arange(GRID_W), rows_n)
    silu_c = jax.nn.silu(c)
    silu_cc = jax.nn.silu(c_ctx)
    for i in range(DEPTH):
        last = i == DEPTH - 1
        lam_init = 0.8 - 0.6 * math.exp(-0.3 * i)
        mod_x = jnp.split((silu_c @ ada_w[i] + ada_b[i])[:, None, :], N_MOD, axis=-1)
        mod_c = jnp.split(silu_cc @ ada_w[i] + ada_b[i], N_MOD, axis=-1)
        hx = modulate(rmsnorm(x, norm1_w[i]), mod_x[0], mod_x[1])
        hc = modulate(rmsnorm(ctx, norm1_w[i]), mod_c[0], mod_c[1])
        y_x, y_c = hybrid_mixer(hx, hc, w_in[i], ret_log_decay[i], ret_gn_w[i], diff_lam[i], lam_init,
                                diff_gn_w[i], conv_w[i], conv_b[i], conv_ln_w[i], conv_ln_b[i], w_out[i],
                                rows, cols, not last)
        x = x + mod_x[2] * y_x
        hx2 = modulate(rmsnorm(x, norm2_w[i]), mod_x[3], mod_x[4])
        x = x + mod_x[5] * sq_relu_mlp(hx2, mlp_w1[i], mlp_w2[i])
        if not last:
            ctx = ctx + mod_c[2] * y_c
            hc2 = modulate(rmsnorm(ctx, norm2_w[i]), mod_c[3], mod_c[4])
            ctx = ctx + mod_c[5] * sq_relu_mlp(hc2, mlp_w1[i], mlp_w2[i])
    return rmsnorm(x, final_norm_w)
```

```cpp
#include <hip/hip_runtime.h>
#include <hip/hip_cooperative_groups.h>
#include <cstdio>
#include <cstdint>
namespace cg = cooperative_groups;
__device__ __forceinline__ int lane_id_volatile() { int l; asm volatile("v_mbcnt_lo_u32_b32 %0, -1, 0\n\tv_mbcnt_hi_u32_b32 %0, -1, %0" : "=v"(l)); return l; }
#define TIDX() (wv__ * 64 + lane_id_volatile())
__device__ __forceinline__ float rfl_f(float x) { return __uint_as_float(__builtin_amdgcn_readfirstlane(__float_as_uint(x))); }
namespace pg8 {
#define PG8_LAS __attribute__((address_space(3)))
typedef unsigned short bf16_t;
typedef short bf16x8 __attribute__((ext_vector_type(8)));
typedef float f32x4 __attribute__((ext_vector_type(4)));
typedef unsigned u32x4 __attribute__((ext_vector_type(4)));
constexpr int BM = 256, BK = 64, HALF = 128, HTB = HALF * BK * 2  , STAGE_BYTES = 8 * HTB, NXCD = 8, WGM = 8;

__host__ __device__ __forceinline__ int lds_byte(int r, int c) { const int st = (r >> 4) * 2 + (c >> 5), rr = r & 15, cc = c & 31, ob = rr * 64 + cc * 2; return st * 1024 + (ob ^ (((ob >> 9) & 1) << 5)); }
__host__ __device__ __forceinline__ void stage_rc(int b, int& R, int& C) { const int st = b / 1024, sb = b % 1024, swz = sb ^ (((sb >> 9) & 1) << 5); R = (st >> 1) * 16 + swz / 64; C = (st & 1) * 32 + (swz % 64) / 2; }
__host__ __device__ __forceinline__ int perm32(int rho) { const int n = rho >> 4, i = rho & 15; return 8 * (i >> 2) + 4 * n + (i & 3); }

struct Unit { int pm, pn, ks; };
struct Gemm { const bf16_t* A; const bf16_t* Bt; int M, N, K; };

struct StaticOrder {
    int nM, nN, nwg, G, c;
    __host__ __device__ void init(int M, int N, int G_, int c_) { nM = M / BM; nN = N / BM; nwg = nM * nN; G = G_; c = c_; }
    __host__ __device__ bool next(int i, Unit& u) const {
        const long L = (long)i * G + c; if (L >= nwg) return false;
        int wgid = (int)L; { const int q = nwg / NXCD, r = nwg % NXCD, xcd = wgid % NXCD, off = wgid / NXCD; wgid = (xcd < r ? xcd * (q + 1) : r * (q + 1) + (xcd - r) * q) + off; }
        const int nig = WGM * nN, gid = wgid / nig, fm = gid * WGM, gsz = (nM - fm) < WGM ? (nM - fm) : WGM;
        u.pm = fm + ((wgid % nig) % gsz); u.pn = (wgid % nig) / gsz; u.ks = -1; return true;
    }
    __device__ __forceinline__ void a_ready(const Unit&) const {}
    __device__ __forceinline__ void done(const Unit&) const {}
};

__device__ __forceinline__ unsigned cvt_pk_bf16(float lo, float hi) { unsigned r; asm volatile("v_cvt_pk_bf16_f32 %0, %1, %2" : "=v"(r) : "v"(lo), "v"(hi)); return r; }
typedef float f32x2 __attribute__((ext_vector_type(2)));
template <class Epi, class Sched, bool ALIGN_EPI = false, bool SP2 = false>
__device__ __forceinline__ void gemm_phase(int wv__, PG8_LAS unsigned char* lds, const Gemm g, const Sched& S, const Epi& E) {
    int tid = TIDX(); asm volatile("" : "+v"(tid));
    const int wid = __builtin_amdgcn_readfirstlane(tid >> 6), lane = tid & 63, wr = wid >> 2, wc = wid & 3, fr = lane & 15, fq = lane >> 4;
    const int K = g.K, nt = K / BK;
    unsigned voffA[2], voffB[2];
#pragma unroll
    for (int i = 0; i < 2; ++i) { int R, C; stage_rc(tid * 16 + i * 8192, R, C); const int Rb = Epi::PERM ? ((R & ~31) + perm32(R & 31)) : R;
        voffA[i] = (unsigned)(R * K + C) * 2u; voffB[i] = (unsigned)(Rb * K + C) * 2u; }
    const size_t kstep = (size_t)(BK * 2);
    const size_t hstep = (size_t)HALF * K * 2;
    const size_t tstep = 2 * hstep;
    const unsigned ldsw = (unsigned)wid * 1024u;
    const int aoff = lds_byte(wr * 64 + fr, fq * 8), boff = lds_byte(wc * 32 + fr, fq * 8);
#define PG8_SA(b, h) (((b) * 2 + (h)) * HTB)
#define PG8_SB(b, h) ((4 + (b) * 2 + (h)) * HTB)
#define PG8_STAGE(bufoff, gbase, voff) do { _Pragma("unroll") for (int _i = 0; _i < 2; ++_i) \
        __builtin_amdgcn_global_load_lds((const unsigned*)((const char*)(gbase) + (voff)[_i]), (PG8_LAS unsigned*)(lds + (bufoff) + ldsw + _i * 8192), 16, 0, 0); } while (0)
#define PG8_LDA(dst, b, h) do { _Pragma("unroll") for (int m = 0; m < 4; ++m) _Pragma("unroll") for (int k = 0; k < 2; ++k) dst[m][k] = *(const PG8_LAS bf16x8*)(lds + PG8_SA(b, h) + aoff + m * 2048 + k * 1024); } while (0)
#define PG8_LDB(dst, b, h) do { _Pragma("unroll") for (int n = 0; n < 2; ++n) _Pragma("unroll") for (int k = 0; k < 2; ++k) dst[n][k] = *(const PG8_LAS bf16x8*)(lds + PG8_SB(b, h) + boff + n * 2048 + k * 1024); } while (0)
#define PG8_MMA(ai, bj, At, Bt) do { __builtin_amdgcn_s_setprio(1); _Pragma("unroll") for (int m = 0; m < 4; ++m) _Pragma("unroll") for (int n = 0; n < 2; ++n) _Pragma("unroll") for (int k = 0; k < 2; ++k) \
        acc[ai][bj][m][n] = __builtin_amdgcn_mfma_f32_16x16x32_bf16(Bt[n][k], At[m][k], acc[ai][bj][m][n], 0, 0, 0); __builtin_amdgcn_s_setprio(0); } while (0)
#define PG8_WAIT_V(n) asm volatile("s_waitcnt vmcnt(" #n ")" ::: "memory")
#define PG8_WAIT_L(n) asm volatile("s_waitcnt lgkmcnt(" #n ")" ::: "memory")
#define PG8_BAR __builtin_amdgcn_s_barrier()
#define PG8_SCHED __builtin_amdgcn_sched_barrier(0)
    Unit cur, nxt; int ui = 0;
    if (!S.next(0, cur)) return;
    f32x4 acc[2][2][4][2];
#pragma unroll
    for (int a = 0; a < 2; ++a)
#pragma unroll
        for (int b = 0; b < 2; ++b)
#pragma unroll
            for (int m = 0; m < 4; ++m)
#pragma unroll
                for (int n = 0; n < 2; ++n) acc[a][b][m][n] = (f32x4){0.f, 0.f, 0.f, 0.f};
    bf16x8 At[4][2], B0[2][2], B1[2][2];
#define PG8_KOFF(u) ((u).ks < 0 ? (size_t)0 : (size_t)(u).ks * (size_t)(K / 4) * 2)
    const char* cA = (const char*)g.A + (size_t)cur.pm * tstep + PG8_KOFF(cur); const char* cB = (const char*)g.Bt + (size_t)cur.pn * tstep + PG8_KOFF(cur);
    S.a_ready(cur);
    if constexpr (SP2) {
        PG8_STAGE(PG8_SB(0, 0), cB, voffB); PG8_STAGE(PG8_SB(0, 1), cB + hstep, voffB); PG8_STAGE(PG8_SA(0, 0), cA, voffA); PG8_STAGE(PG8_SA(0, 1), cA + hstep, voffA);
        if (wr == 1) PG8_BAR;
        PG8_WAIT_V(2); PG8_BAR;
        PG8_STAGE(PG8_SB(1, 0), cB + kstep, voffB); PG8_STAGE(PG8_SA(1, 0), cA + kstep, voffA); PG8_STAGE(PG8_SB(1, 1), cB + hstep + kstep, voffB);
        PG8_WAIT_V(6); PG8_BAR;
    } else {
        PG8_STAGE(PG8_SB(0, 0), cB, voffB); PG8_STAGE(PG8_SA(0, 0), cA, voffA); PG8_STAGE(PG8_SB(0, 1), cB + hstep, voffB); PG8_STAGE(PG8_SA(0, 1), cA + hstep, voffA);
        if (wr == 1) PG8_BAR;
        PG8_WAIT_V(4); PG8_BAR;
        PG8_STAGE(PG8_SB(1, 0), cB + kstep, voffB); PG8_STAGE(PG8_SA(1, 0), cA + kstep, voffA); PG8_STAGE(PG8_SB(1, 1), cB + hstep + kstep, voffB);
        PG8_WAIT_V(6); PG8_BAR;
    }
    for (;;) {
        const bool has_next = S.next(ui + 1, nxt);
        const char* nA = has_next ? (const char*)g.A + (size_t)nxt.pm * tstep + PG8_KOFF(nxt) : cA; const char* nB = has_next ? (const char*)g.Bt + (size_t)nxt.pn * tstep + PG8_KOFF(nxt) : cB;
        const int cnt = cur.ks < 0 ? nt : (nt >> 2);
        for (int t = 0; t < cnt; t += 2) {
            const bool last = (t == cnt - 2);
            const char* a1 = cA + (size_t)(t + 1) * kstep;
            const char* a2 = last ? nA : cA + (size_t)(t + 2) * kstep; const char* b2 = last ? nB : cB + (size_t)(t + 2) * kstep;
            const char* a3 = a2 + kstep; const char* b3 = b2 + kstep;
            if (last && has_next) S.a_ready(nxt);
            if constexpr (SP2) {
            PG8_LDB(B0, 0, 0); PG8_LDB(B1, 0, 1); PG8_SCHED; PG8_LDA(At, 0, 0); PG8_STAGE(PG8_SA(1, 1), a1 + hstep, voffA);
            PG8_WAIT_V(8); PG8_WAIT_L(0); PG8_BAR; PG8_MMA(0, 0, At, B0); PG8_MMA(0, 1, At, B1); PG8_BAR; PG8_SCHED;
            PG8_LDA(At, 0, 1); PG8_STAGE(PG8_SB(0, 0), b2, voffB); PG8_STAGE(PG8_SB(0, 1), b2 + hstep, voffB); PG8_STAGE(PG8_SA(0, 0), a2, voffA);
            PG8_WAIT_V(8); PG8_WAIT_L(0); PG8_BAR; PG8_MMA(1, 0, At, B0); PG8_MMA(1, 1, At, B1); PG8_BAR; PG8_SCHED;
            PG8_LDB(B0, 1, 0); PG8_LDB(B1, 1, 1); PG8_SCHED; PG8_LDA(At, 1, 0); PG8_STAGE(PG8_SA(0, 1), a2 + hstep, voffA);
            PG8_WAIT_V(8); PG8_WAIT_L(0); PG8_BAR; PG8_MMA(0, 0, At, B0); PG8_MMA(0, 1, At, B1); PG8_BAR; PG8_SCHED;
            PG8_LDA(At, 1, 1); PG8_STAGE(PG8_SB(1, 0), b3, voffB); PG8_STAGE(PG8_SB(1, 1), b3 + hstep, voffB); PG8_STAGE(PG8_SA(1, 0), a3, voffA);
            PG8_WAIT_V(8); PG8_WAIT_L(0); PG8_BAR; PG8_MMA(1, 0, At, B0); PG8_MMA(1, 1, At, B1); PG8_BAR; PG8_SCHED;
            } else {
            PG8_LDB(B0, 0, 0); PG8_SCHED; PG8_LDA(At, 0, 0); PG8_STAGE(PG8_SA(1, 1), a1 + hstep, voffA);
            PG8_WAIT_L(8); PG8_BAR; PG8_WAIT_L(0); PG8_MMA(0, 0, At, B0); PG8_BAR; PG8_SCHED;
            PG8_LDB(B1, 0, 1); PG8_STAGE(PG8_SB(0, 0), b2, voffB);
            PG8_BAR; PG8_WAIT_L(0); PG8_MMA(0, 1, At, B1); PG8_BAR;
            PG8_LDA(At, 0, 1); PG8_STAGE(PG8_SA(0, 0), a2, voffA);
            PG8_BAR; PG8_WAIT_L(0); PG8_MMA(1, 0, At, B0); PG8_BAR; PG8_SCHED;
            PG8_STAGE(PG8_SB(0, 1), b2 + hstep, voffB);
            PG8_WAIT_V(6); PG8_BAR; PG8_MMA(1, 1, At, B1); PG8_BAR;
            PG8_LDB(B0, 1, 0); PG8_SCHED; PG8_LDA(At, 1, 0); PG8_STAGE(PG8_SA(0, 1), a2 + hstep, voffA);
            PG8_WAIT_L(8); PG8_BAR; PG8_WAIT_L(0); PG8_MMA(0, 0, At, B0); PG8_BAR; PG8_SCHED;
            PG8_LDB(B1, 1, 1); PG8_STAGE(PG8_SB(1, 0), b3, voffB);
            PG8_BAR; PG8_WAIT_L(0); PG8_MMA(0, 1, At, B1); PG8_BAR;
            PG8_LDA(At, 1, 1); PG8_STAGE(PG8_SA(1, 0), a3, voffA);
            PG8_BAR; PG8_WAIT_L(0); PG8_MMA(1, 0, At, B0); PG8_BAR; PG8_SCHED;
            PG8_STAGE(PG8_SB(1, 1), b3 + hstep, voffB);
            PG8_WAIT_V(6); PG8_BAR; PG8_MMA(1, 1, At, B1); PG8_BAR;
            }
        }
        if constexpr (ALIGN_EPI) { if (wr == 0) PG8_BAR; }
        if constexpr (!Epi::AFTER_DRAIN) { E(acc, cur, wr, wc, fr, fq); S.done(cur); }
        if (!has_next) break;
#pragma unroll
        for (int a = 0; a < 2; ++a)
#pragma unroll
            for (int b = 0; b < 2; ++b)
#pragma unroll
                for (int m = 0; m < 4; ++m)
#pragma unroll
                    for (int n = 0; n < 2; ++n) acc[a][b][m][n] = (f32x4){0.f, 0.f, 0.f, 0.f};
        cur = nxt; cA = nA; cB = nB; ++ui;
        if constexpr (ALIGN_EPI) { if (wr == 1) PG8_BAR; }
    }
    PG8_WAIT_V(0);
    if constexpr (!ALIGN_EPI) { if (wr == 0) PG8_BAR; }
    PG8_BAR;
    if constexpr (Epi::AFTER_DRAIN) { E.fused(acc, cur, wr, wc, fr, fq, lds, wid, lane); S.done(cur); }
#undef PG8_KOFF
#undef PG8_SA
#undef PG8_SB
#undef PG8_STAGE
#undef PG8_LDA
#undef PG8_LDB
#undef PG8_MMA
#undef PG8_WAIT_V
#undef PG8_WAIT_L
#undef PG8_BAR
#undef PG8_SCHED
}
}

constexpr int DM = 1024, NB = 16, SEQ = 2048, CTXL = 256, NLAT = NB * SEQ, NCTX = NB * CTXL, MTOT = NLAT + NCTX;
constexpr int INW = 3072, DFF = 4096, NMODW = 6 * DM;
constexpr float EPSN = 1e-6f;
constexpr size_t MiB = 1u << 20;
constexpr size_t WS_WIN = 0, WS_WOUT = 12 * MiB, WS_W1 = 16 * MiB, WS_W2 = 32 * MiB;
constexpr size_t WS_MOD = 48 * MiB, WS_SCAL = 49 * MiB, WS_CTXRES = 50 * MiB, WS_SCR = 66 * MiB, WS_XN = 98 * MiB, WS_P = 170 * MiB, WS_MIX = 386 * MiB, WS_H = WS_P, WS_CTL = 458 * MiB, WS_RSQ = 459 * MiB  , WS_SB = 460 * MiB  , WS_PART2 = 462 * MiB  , WS_END = 494 * MiB;
constexpr size_t CTL_ZERO_BYTES = 2 * MiB;
constexpr int LDS_BYTES = 148480;

#define LAS __attribute__((address_space(3)))
typedef unsigned short bf16;
typedef unsigned v4u __attribute__((ext_vector_type(4)));
typedef unsigned v2u __attribute__((ext_vector_type(2)));
typedef float f32x4 __attribute__((ext_vector_type(4)));
typedef short bf16x8 __attribute__((ext_vector_type(8)));
typedef short s16x4 __attribute__((ext_vector_type(4)));
typedef float f32x16 __attribute__((ext_vector_type(16)));

__device__ __forceinline__ unsigned f2bf(float f) { unsigned u = __builtin_bit_cast(unsigned, f); return (u + 0x7fffu + ((u >> 16) & 1u)) >> 16; }
__device__ __forceinline__ unsigned pk2(float lo, float hi) { return f2bf(lo) | (f2bf(hi) << 16); }
__device__ __forceinline__ float bf2f(unsigned short h) { return __builtin_bit_cast(float, (unsigned)h << 16); }
__device__ __forceinline__ float wave_sum(float v) {
#pragma unroll
    for (int o = 1; o < 64; o <<= 1) v += __shfl_xor(v, o);
    return v;
}
__device__ __forceinline__ float half_sum32(float v) {
#pragma unroll
    for (int o = 1; o < 32; o <<= 1) v += __shfl_xor(v, o);
    return v;
}
__device__ __forceinline__ float fast_sigmoid(float v) { return __builtin_amdgcn_rcpf(1.f + __builtin_amdgcn_exp2f(-1.4426950408889634f * v)); }

__host__ __device__ __forceinline__ int win_src_col(int p) {
    const int pn = p >> 8, q = p & 255, bj = q >> 7, wc = (q >> 5) & 3, j = q & 31;
    if (pn < 4) return pn * 256 + 64 * wc + 32 * bj + j;
    if (pn < 8) return pn * 256 + 64 * wc + 16 * bj + j + ((j >= 16) ? 16 : 0);
    if (pn < 10) return p;
    return 2560 + 256 * bj + 128 * (pn - 10) + 32 * wc + j;
}
constexpr float QSCALE = 0.125f * 1.4426950408889634f;
constexpr float LOG2_10000 = 13.287712379549449f;
constexpr float INV_2PI = 0.15915494309189535f;

template <bool FUSED>
struct EpiIn {
    static constexpr bool PERM = true, AFTER_DRAIN = false;
    bf16* P; const float* rowsq; const float* S;
    __device__ __forceinline__ void operator()(const pg8::f32x4 (&acc0)[2][2][4][2], const pg8::Unit& u, int wr, int wc, int fr, int fq) const {
        const int pn = u.pn; const int row0 = u.pm * 256 + wr * 64 + fr; const bool latent = u.pm < (NLAT / 256);
        pg8::f32x4 acc[2][2][4][2];
        if (FUSED) {
            const float* sp = S + (size_t)(latent ? (u.pm >> 3) : 16) * INW + pn * 256 + wc * 32 + 8 * fq;
            pg8::f32x4 sv[2][2];
#pragma unroll
            for (int bj = 0; bj < 2; ++bj)
#pragma unroll
                for (int n = 0; n < 2; ++n) sv[bj][n] = *(const pg8::f32x4*)(sp + bj * 128 + 4 * n);
#pragma unroll
            for (int ai = 0; ai < 2; ++ai)
#pragma unroll
                for (int m = 0; m < 4; ++m) { const float rs = __builtin_amdgcn_rsqf(rowsq[row0 + ai * 128 + m * 16] * (1.f / DM) + EPSN);
#pragma unroll
                    for (int bj = 0; bj < 2; ++bj)
#pragma unroll
                        for (int n = 0; n < 2; ++n) acc[ai][bj][m][n] = acc0[ai][bj][m][n] * rs + sv[bj][n]; }
        } else {
#pragma unroll
            for (int ai = 0; ai < 2; ++ai)
#pragma unroll
                for (int bj = 0; bj < 2; ++bj)
#pragma unroll
                    for (int m = 0; m < 4; ++m)
#pragma unroll
                        for (int n = 0; n < 2; ++n) acc[ai][bj][m][n] = acc0[ai][bj][m][n];
        }
        if (pn < 8) {
            const bool ret = pn < 4;
            const bool rope = latent && (pn < 2 || pn >= 4);
            const float exstep = ret ? (1.f / 32.f) : (1.f / 16.f); const float ex0 = ret ? (float)(8 * fq) * (1.f / 32.f) : (float)((8 * fq) & 15) * (1.f / 16.f);
            const float sc = (pn == 1) ? 0.125f : ((pn == 4 || pn == 5) ? QSCALE : 1.f);
            const int cbase = ret ? (pn * 256 + 64 * wc + 8 * fq) : (pn * 256 + 64 * wc + 8 * fq);
#pragma unroll
            for (int ai = 0; ai < 2; ++ai)
#pragma unroll
                for (int m = 0; m < 4; ++m) {
                    const int row = row0 + ai * 128 + m * 16; const int t = row & (SEQ - 1);
                    const float pos = ret ? (float)t : ((fq < 2) ? (float)(t >> 6) : (float)(t & 63));
                    float o1[8], o2[8];
#pragma unroll
                    for (int n = 0; n < 2; ++n)
#pragma unroll
                        for (int e = 0; e < 4; ++e) {
                            const float x1 = acc[ai][0][m][n][e], x2 = acc[ai][1][m][n][e];
                            float y1 = x1, y2 = x2;
                            if (rope) { float rv = pos * (__builtin_amdgcn_exp2f(-(ex0 + (float)(n * 4 + e) * exstep + 0.f * pos) * LOG2_10000) * INV_2PI); rv = rv - __builtin_floorf(rv); const float sn = __builtin_amdgcn_sinf(rv), cs = __builtin_amdgcn_cosf(rv);
                                y1 = x1 * cs - x2 * sn; y2 = x2 * cs + x1 * sn; }
                            if (pn == 3) { y1 = y1 * fast_sigmoid(y1); y2 = y2 * fast_sigmoid(y2); }
                            o1[n * 4 + e] = y1 * sc; o2[n * 4 + e] = y2 * sc;
                        }
                    bf16* rp = P + (size_t)row * INW + cbase;
                    v4u w1, w2; w1.x = pk2(o1[0], o1[1]); w1.y = pk2(o1[2], o1[3]); w1.z = pk2(o1[4], o1[5]); w1.w = pk2(o1[6], o1[7]);
                    w2.x = pk2(o2[0], o2[1]); w2.y = pk2(o2[2], o2[3]); w2.z = pk2(o2[4], o2[5]); w2.w = pk2(o2[6], o2[7]);
                    *(v4u*)rp = w1; *(v4u*)(rp + 32) = w2;
                    __builtin_amdgcn_sched_barrier(0);
                }
        } else if (pn < 10) {
            const int cbase = pn * 256 + 32 * wc + 8 * fq;
#pragma unroll
            for (int ai = 0; ai < 2; ++ai)
#pragma unroll
                for (int m = 0; m < 4; ++m) {
                    bf16* rp = P + (size_t)(row0 + ai * 128 + m * 16) * INW + cbase;
#pragma unroll
                    for (int bj = 0; bj < 2; ++bj) { const pg8::f32x4 a = acc[ai][bj][m][0], b = acc[ai][bj][m][1];
                        v4u w; w.x = pk2(a[0], a[1]); w.y = pk2(a[2], a[3]); w.z = pk2(b[0], b[1]); w.w = pk2(b[2], b[3]); *(v4u*)(rp + bj * 128) = w; }
                }
        } else {
            const int cbase = 2560 + 128 * (pn - 10) + 32 * wc + 8 * fq;
#pragma unroll
            for (int ai = 0; ai < 2; ++ai)
#pragma unroll
                for (int m = 0; m < 4; ++m) {
                    bf16* rp = P + (size_t)(row0 + ai * 128 + m * 16) * INW + cbase;
                    float o[8];
#pragma unroll
                    for (int n = 0; n < 2; ++n)
#pragma unroll
                        for (int e = 0; e < 4; ++e) o[n * 4 + e] = acc[ai][0][m][n][e] * fast_sigmoid(acc[ai][1][m][n][e]);
                    v4u w; w.x = pk2(o[0], o[1]); w.y = pk2(o[2], o[3]); w.z = pk2(o[4], o[5]); w.w = pk2(o[6], o[7]); *(v4u*)rp = w;
                }
        }
    }
};
struct DownL0Order {
    pg8::StaticOrder lat; int c;
    __device__ void init(int G_, int c_) { lat.init(NLAT, DM, G_, c_); c = c_; }
    __device__ bool next(int i, pg8::Unit& u) const {
        if (i < 2) return lat.next(i, u);
        if (i == 2) { const int tile = c >> 2; u.pm = NLAT / 256 + (tile >> 2); u.pn = tile & 3; u.ks = c & 3; return true; }
        return false;
    }
    __device__ __forceinline__ void a_ready(const pg8::Unit&) const {}
    __device__ __forceinline__ void done(const pg8::Unit&) const {}
};
struct EpiRes {
    static constexpr bool PERM = true, AFTER_DRAIN = false;
    const float* baseL; const float* baseC; float* outL; float* outC; const float* modl; int gidx;
    bf16* XN; const float* nw; const float* modN; int sci; float* rowsq; float* part0; float* part1;
    __device__ __forceinline__ void operator()(const pg8::f32x4 (&acc)[2][2][4][2], const pg8::Unit& u, int wr, int wc, int fr, int fq) const {
        const bool latent = u.pm < (NLAT / 256);
        if (u.ks >= 0) {
            float* pp = (u.ks < 2 ? part0 : part1) + (size_t)(u.ks & 1) * NCTX * DM + (size_t)((u.pm - NLAT / 256) * 256 + wr * 64 + fr) * DM + u.pn * 256 + wc * 32 + 8 * fq;
#pragma unroll
            for (int ai = 0; ai < 2; ++ai)
#pragma unroll
                for (int m = 0; m < 4; ++m)
#pragma unroll
                    for (int bj = 0; bj < 2; ++bj)
#pragma unroll
                        for (int n = 0; n < 2; ++n) *(pg8::f32x4*)(pp + (size_t)(ai * 128 + m * 16) * DM + bj * 128 + 4 * n) = acc[ai][bj][m][n];
            return;
        }
        const int rowt = (latent ? u.pm * 256 : (u.pm - NLAT / 256) * 256) + wr * 64 + fr;
        const int rowg = u.pm * 256 + wr * 64 + fr;
        const float* base = latent ? baseL : baseC; float* out = latent ? outL : outC;
        const int b = latent ? (u.pm >> 3) : 16;
        const int col0 = u.pn * 256 + wc * 32 + 8 * fq;
        const float* gp = modl + (size_t)b * NMODW + gidx * DM + col0;
        pg8::f32x4 gv[2][2], nv[2][2];
#pragma unroll
        for (int bj = 0; bj < 2; ++bj)
#pragma unroll
            for (int n = 0; n < 2; ++n) { gv[bj][n] = *(const pg8::f32x4*)(gp + bj * 128 + 4 * n);
                if (XN) nv[bj][n] = *(const pg8::f32x4*)(nw + col0 + bj * 128 + 4 * n) * (*(const pg8::f32x4*)(modN + (size_t)b * NMODW + sci * DM + col0 + bj * 128 + 4 * n) + 1.f); }
#pragma unroll
        for (int ai = 0; ai < 2; ++ai)
#pragma unroll
            for (int m = 0; m < 4; ++m) { const size_t off = (size_t)(rowt + ai * 128 + m * 16) * DM + col0; float ss = 0.f;
#pragma unroll
                for (int bj = 0; bj < 2; ++bj) { pg8::f32x4 x[2];
#pragma unroll
                    for (int n = 0; n < 2; ++n) { const pg8::f32x4 bs = __builtin_nontemporal_load((const pg8::f32x4*)(base + off + bj * 128 + 4 * n));
                        x[n] = bs + gv[bj][n] * acc[ai][bj][m][n];
                        *(pg8::f32x4*)(out + off + bj * 128 + 4 * n) = x[n]; }
                    if (XN) { ss += (x[0][0] * x[0][0] + x[0][1] * x[0][1]) + (x[0][2] * x[0][2] + x[0][3] * x[0][3]) + (x[1][0] * x[1][0] + x[1][1] * x[1][1]) + (x[1][2] * x[1][2] + x[1][3] * x[1][3]);
                        const pg8::f32x4 y0 = x[0] * nv[bj][0], y1 = x[1] * nv[bj][1];
                        v4u w; w.x = pk2(y0[0], y0[1]); w.y = pk2(y0[2], y0[3]); w.z = pk2(y1[0], y1[1]); w.w = pk2(y1[2], y1[3]);
                        *(v4u*)(XN + (size_t)(rowg + ai * 128 + m * 16) * DM + col0 + bj * 128) = w; } }
                if (XN) { ss += __shfl_xor(ss, 16); ss += __shfl_xor(ss, 32);
                    if (fq == 0) atomicAdd(rowsq + rowg + ai * 128 + m * 16, ss); } }
    }
};
struct EpiUp {
    static constexpr bool PERM = true, AFTER_DRAIN = false;
    bf16* H; const float* rowsq; const float* S;
    __device__ __forceinline__ void operator()(const pg8::f32x4 (&acc)[2][2][4][2], const pg8::Unit& u, int wr, int wc, int fr, int fq) const {
        const int row0 = u.pm * 256 + wr * 64 + fr, col0 = u.pn * 256 + wc * 32 + 8 * fq;
        const float* sp = S + (size_t)((u.pm < NLAT / 256) ? (u.pm >> 3) : 16) * DFF + col0;
        pg8::f32x4 sv[2][2];
#pragma unroll
        for (int bj = 0; bj < 2; ++bj)
#pragma unroll
            for (int n = 0; n < 2; ++n) sv[bj][n] = *(const pg8::f32x4*)(sp + bj * 128 + 4 * n);
#pragma unroll
        for (int ai = 0; ai < 2; ++ai)
#pragma unroll
            for (int m = 0; m < 4; ++m) { bf16* rp = H + (size_t)(row0 + ai * 128 + m * 16) * DFF + col0;
                const float rs = __builtin_amdgcn_rsqf(rowsq[row0 + ai * 128 + m * 16] * (1.f / DM) + EPSN);
#pragma unroll
                for (int bj = 0; bj < 2; ++bj) { pg8::f32x4 a = acc[ai][bj][m][0] * rs + sv[bj][0], b = acc[ai][bj][m][1] * rs + sv[bj][1];
#pragma unroll
                    for (int e = 0; e < 4; ++e) { const float x = fmaxf(a[e], 0.f), y = fmaxf(b[e], 0.f); a[e] = x * x; b[e] = y * y; }
                    v4u w; w.x = pk2(a[0], a[1]); w.y = pk2(a[2], a[3]); w.z = pk2(b[0], b[1]); w.w = pk2(b[2], b[3]); *(v4u*)(rp + bj * 128) = w; } }
    }
};
#define XB_TMO      128
#define XB_XCNT(j)  (256  + 64 * (j))
#define XB_XSUB(j)  (1280 + 64 * (j))
#define XB_XGEN(j)  (2304 + 64 * (j))
#define XB_TOP      3328
#define XB_TOPGEN   3392
#define XCD_BAR_WORDS 3456
#define XB_SPIN_CAP (1u << 18)

__device__ __forceinline__ unsigned xb_ld(unsigned* p)              { return __hip_atomic_load(p, __ATOMIC_RELAXED, __HIP_MEMORY_SCOPE_AGENT); }
__device__ __forceinline__ unsigned xb_add(unsigned* p, unsigned v) { return __hip_atomic_fetch_add(p, v, __ATOMIC_RELAXED, __HIP_MEMORY_SCOPE_AGENT); }
__device__ __forceinline__ unsigned xb_xcc_id() { return (unsigned)__builtin_amdgcn_s_getreg((3 << 11) | 20) & 0xFu; }
#define XB_SPIN(cond, bar) do { unsigned _sp = 0; while (cond) { __builtin_amdgcn_s_sleep(1); \
    if ((++_sp & 255u) == 0u) { if (xb_ld(&(bar)[XB_TMO])) break; if (_sp > XB_SPIN_CAP) { atomicAdd(&(bar)[XB_TMO], 1u); break; } } } } while (0)

struct XcdBarrier {
    unsigned* bar; unsigned x;
    volatile LAS unsigned* st;
};

__device__ __forceinline__ XcdBarrier xcd_barrier_post(int wv__, unsigned* bar, volatile LAS unsigned* st) {
    XcdBarrier b; b.bar = bar; b.x = xb_xcc_id(); b.st = st;
    if (TIDX() == 0) (void)xb_add(&bar[XB_XCNT(b.x)], 1u);
    return b;
}
__device__ __forceinline__ void xcd_barrier_complete(unsigned* bar, unsigned x, unsigned& nloc, unsigned& nx) {
    const unsigned G = gridDim.x * gridDim.y * gridDim.z;
    unsigned sum, cnt, mine, sp = 0u;
    for (;;) {
        sum = 0u; cnt = 0u; mine = 0u;
#pragma unroll
        for (unsigned j = 0; j < 16; ++j) { const unsigned c = xb_ld(&bar[XB_XCNT(j)]); sum += c; cnt += (c > 0u) ? 1u : 0u; mine = (j == x) ? c : mine; }
        if (sum == G) break;
        __builtin_amdgcn_s_sleep(1);
        if ((++sp & 255u) == 0u) { if (xb_ld(&bar[XB_TMO])) break; if (sp > XB_SPIN_CAP) { atomicAdd(&bar[XB_TMO], 1u); break; } }
    }
    nloc = mine > 0u ? mine : 1u; nx = cnt > 0u ? cnt : 1u;
}

__device__ __forceinline__ void xcd_barrier(int wv__, const XcdBarrier& b) {
    asm volatile("s_waitcnt vmcnt(0)" ::: "memory");
    __syncthreads();
    if (TIDX() == 0) {
        unsigned* bar = b.bar;
        __builtin_amdgcn_s_waitcnt(0);
        unsigned nloc = b.st[0], nx = b.st[1];
        if (nloc == 0u) { xcd_barrier_complete(bar, b.x, nloc, nx); b.st[0] = nloc; b.st[1] = nx; }
        const unsigned old = xb_add(&bar[XB_XSUB(b.x)], 1u);
        const unsigned gen = old / nloc;
        if (old + 1u == (gen + 1u) * nloc) {
            __builtin_amdgcn_fence(__ATOMIC_RELEASE, "agent");
            asm volatile("s_waitcnt vmcnt(0)" ::: "memory");
            const unsigned og = xb_add(&bar[XB_TOP], 1u);
            const unsigned tg = og / nx;
            if (og + 1u == (tg + 1u) * nx) xb_add(&bar[XB_TOPGEN], 1u);
            else XB_SPIN(xb_ld(&bar[XB_TOPGEN]) == tg, bar);
            __builtin_amdgcn_fence(__ATOMIC_ACQUIRE, "agent");
            xb_add(&bar[XB_XGEN(b.x)], 1u);
            asm volatile("s_waitcnt vmcnt(0)" ::: "memory");
        } else {
            XB_SPIN(xb_ld(&bar[XB_XGEN(b.x)]) == gen, bar);
            __builtin_amdgcn_fence(__ATOMIC_ACQUIRE, "agent");
            asm volatile("s_waitcnt vmcnt(0)" ::: "memory");
        }
    }
    __syncthreads();
}

namespace att {
#define SBAR() __builtin_amdgcn_sched_barrier(0)
#define KSWZ64(row, colB) ((row) * 128 + ((colB) ^ ((((row) >> 1) & 7) << 4)))
constexpr int LV = 0, LK = 32768, LWS = 49152;
__device__ __forceinline__ int crow(int r, int hi) { return (r & 3) + 8 * (r >> 2) + 4 * hi; }
__device__ __forceinline__ unsigned cvtpk(float lo, float hi) { unsigned r; asm volatile("v_cvt_pk_bf16_f32 %0, %1, %2" : "=v"(r) : "v"(lo), "v"(hi)); return r; }
template <int NCB> __device__ __forceinline__ int v_st(int k, int c) { const int kk = (k & ~0xC) | ((k & 4) << 1) | ((k & 8) >> 1); return ((kk >> 3) * NCB + (c >> 5)) * 512 + ((kk & 7) * 32 + (c & 31)) * 2; }
__device__ __forceinline__ int v_rd_base(int lane) { return ((lane & 3) << 3) | (((lane >> 2) & 3) << 6) | (((lane >> 4) & 1) << 5) | (((lane >> 5) & 1) << 8); }
template <int OFF> __device__ __forceinline__ s16x4 tr_read(int vb) { s16x4 r; asm volatile("ds_read_b64_tr_b16 %0, %1 offset:%2" : "=&v"(r) : "v"(vb), "i"(OFF) : "memory"); return r; }
template <int NCB, int D0> __device__ __forceinline__ void pv_one(f32x16& od, int vb, bf16x8 pa0, bf16x8 pa1, bf16x8 pa2, bf16x8 pa3) {
#define VOFF(ks, half) (D0 * 512 + (ks) * (NCB * 1024) + (half) * (NCB * 512))
    const s16x4 l0 = tr_read<VOFF(0, 0)>(vb), h0 = tr_read<VOFF(0, 1)>(vb), l1 = tr_read<VOFF(1, 0)>(vb), h1 = tr_read<VOFF(1, 1)>(vb);
    const s16x4 l2 = tr_read<VOFF(2, 0)>(vb), h2 = tr_read<VOFF(2, 1)>(vb), l3 = tr_read<VOFF(3, 0)>(vb), h3 = tr_read<VOFF(3, 1)>(vb);
#undef VOFF
    asm volatile("s_waitcnt lgkmcnt(0)" ::: "memory"); SBAR();
#define PK(L, H) (bf16x8){L[0], L[1], L[2], L[3], H[0], H[1], H[2], H[3]}
    od = __builtin_amdgcn_mfma_f32_32x32x16_bf16(pa0, PK(l0, h0), od, 0, 0, 0);
    od = __builtin_amdgcn_mfma_f32_32x32x16_bf16(pa1, PK(l1, h1), od, 0, 0, 0);
    od = __builtin_amdgcn_mfma_f32_32x32x16_bf16(pa2, PK(l2, h2), od, 0, 0, 0);
    od = __builtin_amdgcn_mfma_f32_32x32x16_bf16(pa3, PK(l3, h3), od, 0, 0, 0);
#undef PK
}
#define PK4(P, BASE, OUT) do { unsigned a0 = cvtpk(P[BASE + 0], P[BASE + 1]), a1 = cvtpk(P[BASE + 2], P[BASE + 3]);   \
    unsigned b0 = cvtpk(P[BASE + 4], P[BASE + 5]), b1 = cvtpk(P[BASE + 6], P[BASE + 7]);                              \
    auto r0 = __builtin_amdgcn_permlane32_swap(a0, b0, false, false); auto r1 = __builtin_amdgcn_permlane32_swap(a1, b1, false, false); \
    v4u w = {r0[0], r1[0], r0[1], r1[1]}; OUT = *reinterpret_cast<bf16x8*>(&w); } while (0)

struct CoreArgs {
    const bf16* P;
    long qrow;
    int qcol, kcol, vcol;
    long kr_a; int nt_a;
    long kr_b; int nt_b;
    int ipos0;
    float lf, lb;
};
template <int DV, int MODE>
__device__ __forceinline__ void attn_core(int wv__, char* lds, const CoreArgs& A, f32x16 (&o)[DV / 32], float& l_reg) {
    constexpr int NCB = DV / 32, VBYTES = 64 * DV * 2, KBYTES = 8192; constexpr float THR = 8.f;
    int tid = TIDX(); asm volatile("" : "+v"(tid));
    const int wid = tid >> 6, lane = tid & 63, r32 = lane & 31, hi = lane >> 5;
    float* al_l = (float*)(lds + LWS) + wid * 64;
    const int NT = A.nt_a + A.nt_b;
    bf16x8 qr[4];
    { const bf16* Qw = A.P + (size_t)(A.qrow + wid * 32 + r32) * INW + A.qcol + hi * 8;
#pragma unroll
      for (int d0 = 0; d0 < 4; ++d0) qr[d0] = *reinterpret_cast<const bf16x8*>(Qw + d0 * 16); }
#pragma unroll
    for (int d = 0; d < NCB; ++d) o[d] = f32x16{};
    float m_reg = -1e30f; l_reg = 0.f;
    const int kr = tid >> 3, kc = (tid & 7) * 8;
    const int kdst = KSWZ64(kr, kc * 2);
    int vr0, vc0, vdst0, vdst1;
    if (DV == 128) { vr0 = tid >> 4; vc0 = (tid & 15) * 8; vdst0 = v_st<NCB>(vr0, vc0); vdst1 = v_st<NCB>(vr0 + 32, vc0); }
    else { vr0 = tid >> 3; vc0 = (tid & 7) * 8; vdst0 = v_st<NCB>(vr0, vc0); vdst1 = 0; }
    const int vb0 = (int)(uintptr_t)(lds + LV) + v_rd_base(lane);
    bf16x8 sk, sv0, sv1;
#define KROW(t) ((t) < A.nt_a ? A.kr_a + 64 * (t) : A.kr_b + 64 * ((t) - A.nt_a))
#define SLOAD(t) do { const long kb_ = KROW(t); sk = *reinterpret_cast<const bf16x8*>(A.P + (size_t)(kb_ + kr) * INW + A.kcol + kc); \
        sv0 = *reinterpret_cast<const bf16x8*>(A.P + (size_t)(kb_ + vr0) * INW + A.vcol + vc0); \
        if (DV == 128) sv1 = *reinterpret_cast<const bf16x8*>(A.P + (size_t)(kb_ + vr0 + 32) * INW + A.vcol + vc0); } while (0)
#define SWRITE(b) do { *(bf16x8*)(lds + LK + (b) * KBYTES + kdst) = sk; *(bf16x8*)(lds + LV + (b) * VBYTES + vdst0) = sv0; \
        if (DV == 128) *(bf16x8*)(lds + LV + (b) * VBYTES + vdst1) = sv1; } while (0)
    SLOAD(0); SWRITE(0); __syncthreads();
    const int iq0w = A.ipos0 + wid * 32, iq = iq0w + r32;
    float KF[16], KB[16];
    if (MODE == 1) {
#pragma unroll
        for (int r = 0; r < 16; ++r) { const float jj = (float)((r & 3) + 8 * (r >> 2)); KF[r] = __builtin_amdgcn_exp2f(-A.lf * jj); KB[r] = __builtin_amdgcn_exp2f(A.lb * jj); }
    }
#pragma unroll 1
    for (int t = 0; t < NT; ++t) {
        const int buf = t & 1;
        if (t + 1 < NT) SLOAD(t + 1);
        f32x16 p0 = f32x16{}, p1 = f32x16{};
        { const char* Ks = lds + LK + buf * KBYTES;
#pragma unroll
          for (int d0 = 0; d0 < 4; ++d0) { const int cb = (d0 * 16 + hi * 8) * 2;
            const bf16x8 b0 = *reinterpret_cast<const bf16x8*>(Ks + KSWZ64(r32, cb));
            const bf16x8 b1 = *reinterpret_cast<const bf16x8*>(Ks + KSWZ64(32 + r32, cb));
            p0 = __builtin_amdgcn_mfma_f32_32x32x16_bf16(b0, qr[d0], p0, 0, 0, 0);
            p1 = __builtin_amdgcn_mfma_f32_32x32x16_bf16(b1, qr[d0], p1, 0, 0, 0); } }
        if (MODE == 0) {
            float pmax = p0[0];
#pragma unroll
            for (int r = 1; r < 16; ++r) pmax = fmaxf(pmax, p0[r]);
#pragma unroll
            for (int r = 0; r < 16; ++r) pmax = fmaxf(pmax, p1[r]);
            { auto rr = __builtin_amdgcn_permlane32_swap(__float_as_uint(pmax), __float_as_uint(pmax), false, false);
              pmax = fmaxf(__uint_as_float(rr[0]), __uint_as_float(rr[1])); }
            float mn, alpha;
            if (__builtin_expect(__all(pmax - m_reg <= THR), 1)) { mn = m_reg; alpha = 1.f; }
            else { mn = fmaxf(m_reg, pmax); alpha = __builtin_amdgcn_exp2f(m_reg - mn); m_reg = mn; }
#pragma unroll
            for (int r = 0; r < 16; ++r) { p0[r] = __builtin_amdgcn_exp2f(p0[r] - mn); p1[r] = __builtin_amdgcn_exp2f(p1[r] - mn); }
            float ps = 0.f;
#pragma unroll
            for (int r = 0; r < 16; ++r) ps += p0[r] + p1[r];
            { auto rr = __builtin_amdgcn_permlane32_swap(__float_as_uint(ps), __float_as_uint(ps), false, false);
              ps = __uint_as_float(rr[0]) + __uint_as_float(rr[1]); }
            l_reg = l_reg * alpha + ps;
            if (__any(alpha < 1.f)) { if (hi == 0) al_l[r32] = alpha; asm volatile("s_waitcnt lgkmcnt(0)" ::: "memory");
#pragma unroll
                for (int d = 0; d < NCB; ++d)
#pragma unroll
                    for (int r = 0; r < 16; ++r) o[d][r] *= al_l[crow(r, hi)];
            }
        } else {
            if (t < A.nt_a) {
                const int rel = iq0w - 64 * t;
                if (rel > 63) {
                    const float e = A.lf * (float)(iq - 64 * t - 4 * hi);
                    const float R0 = __builtin_amdgcn_exp2f(e), R1 = __builtin_amdgcn_exp2f(e - 32.f * A.lf);
#pragma unroll
                    for (int r = 0; r < 16; ++r) { p0[r] *= R0 * KF[r]; p1[r] *= R1 * KF[r]; }
                } else if (rel < -31) {
                    const float e = A.lb * (float)(64 * t + 4 * hi - iq);
                    const float R0 = __builtin_amdgcn_exp2f(e), R1 = __builtin_amdgcn_exp2f(e + 32.f * A.lb);
#pragma unroll
                    for (int r = 0; r < 16; ++r) { p0[r] *= R0 * KB[r]; p1[r] *= R1 * KB[r]; }
                } else {
                    const int dj0 = iq - 64 * t - 4 * hi;
#pragma unroll
                    for (int r = 0; r < 16; ++r) {
                        const int d0_ = dj0 - ((r & 3) + 8 * (r >> 2)), d1_ = d0_ - 32;
                        const float f0 = (float)d0_, f1 = (float)d1_;
                        float e0 = __builtin_amdgcn_exp2f(d0_ >= 0 ? A.lf * f0 : -A.lb * f0); if (d0_ == 0) e0 += 1.f;
                        float e1 = __builtin_amdgcn_exp2f(d1_ >= 0 ? A.lf * f1 : -A.lb * f1); if (d1_ == 0) e1 += 1.f;
                        p0[r] *= e0; p1[r] *= e1;
                    }
                }
            } else {
                const int m0 = 64 * (t - A.nt_a) + 4 * hi;
                const float ef = A.lf * (float)(iq + CTXL - m0), eb = A.lb * (float)(SEQ - iq + m0);
                const float F0 = __builtin_amdgcn_exp2f(ef), F1 = __builtin_amdgcn_exp2f(ef - 32.f * A.lf), B0 = __builtin_amdgcn_exp2f(eb), B1 = __builtin_amdgcn_exp2f(eb + 32.f * A.lb);
#pragma unroll
                for (int r = 0; r < 16; ++r) { p0[r] *= F0 * KF[r] + B0 * KB[r]; p1[r] *= F1 * KF[r] + B1 * KB[r]; }
            }
        }
        bf16x8 pa0, pa1, pa2, pa3;
        PK4(p0, 0, pa0); PK4(p0, 8, pa1); PK4(p1, 0, pa2); PK4(p1, 8, pa3);
        SBAR();
        { const int vb = vb0 + buf * VBYTES;
          pv_one<NCB, 0>(o[0], vb, pa0, pa1, pa2, pa3); pv_one<NCB, 1>(o[1], vb, pa0, pa1, pa2, pa3);
          if constexpr (NCB == 4) { pv_one<NCB, 2>(o[2], vb, pa0, pa1, pa2, pa3); pv_one<NCB, 3>(o[3], vb, pa0, pa1, pa2, pa3); } }
        if (t + 1 < NT) SWRITE(buf ^ 1);
        __syncthreads();
    }
#undef KROW
#undef SLOAD
#undef SWRITE
}

template <int DV>
__device__ __forceinline__ bool attn_core_fast(int wv__, char* lds, const CoreArgs& A, f32x16 (&o)[DV / 32], float& l_reg) {
    constexpr int NCB = DV / 32, VBYTES = 64 * DV * 2, KBYTES = 8192; constexpr float THR = 8.f;
    static_assert(DV == 128, "softmax core is written for 128 value columns");
    int tid = TIDX(); asm volatile("" : "+v"(tid));
    const int wid = tid >> 6, lane = tid & 63, r32 = lane & 31, hi = lane >> 5;
    float* al_l = (float*)(lds + LWS) + wid * 64;
    const int NT = A.nt_a + A.nt_b;
    bf16x8 qr[4];
    { const bf16* Qw = A.P + (size_t)(A.qrow + wid * 32 + r32) * INW + A.qcol + hi * 8;
#pragma unroll
      for (int d0 = 0; d0 < 4; ++d0) qr[d0] = *reinterpret_cast<const bf16x8*>(Qw + d0 * 16); }
#pragma unroll
    for (int d = 0; d < NCB; ++d) o[d] = f32x16{};
    float m_reg = -1e30f; l_reg = 0.f;
    const int kr = tid >> 3, kc = (tid & 7) * 8;
    const int kdst = KSWZ64(kr, kc * 2);
    const int vr0 = tid >> 4, vc0 = (tid & 15) * 8, vdst0 = v_st<NCB>(vr0, vc0), vdst1 = v_st<NCB>(vr0 + 32, vc0);
    const int vb0 = (int)(uintptr_t)(lds + LV) + v_rd_base(lane);
    bf16x8 sk, sv0, sv1;
#define KROW(t) ((t) < A.nt_a ? A.kr_a + 64 * (t) : A.kr_b + 64 * ((t) - A.nt_a))
#define SLOAD(t) do { const long kb_ = KROW(t); sk = *reinterpret_cast<const bf16x8*>(A.P + (size_t)(kb_ + kr) * INW + A.kcol + kc); \
        sv0 = *reinterpret_cast<const bf16x8*>(A.P + (size_t)(kb_ + vr0) * INW + A.vcol + vc0); \
        sv1 = *reinterpret_cast<const bf16x8*>(A.P + (size_t)(kb_ + vr0 + 32) * INW + A.vcol + vc0); } while (0)
#define SWRITE(b) do { *(bf16x8*)(lds + LK + (b) * KBYTES + kdst) = sk; *(bf16x8*)(lds + LV + (b) * VBYTES + vdst0) = sv0; \
        *(bf16x8*)(lds + LV + (b) * VBYTES + vdst1) = sv1; } while (0)
#define QKT(P0, P1, b) do { const char* Ks = lds + LK + (b) * KBYTES; P0 = f32x16{}; P1 = f32x16{}; \
        _Pragma("unroll") for (int d0 = 0; d0 < 4; ++d0) { const int cb = (d0 * 16 + hi * 8) * 2; \
            const bf16x8 b0 = *reinterpret_cast<const bf16x8*>(Ks + KSWZ64(r32, cb)); const bf16x8 b1 = *reinterpret_cast<const bf16x8*>(Ks + KSWZ64(32 + r32, cb)); \
            P0 = __builtin_amdgcn_mfma_f32_32x32x16_bf16(b0, qr[d0], P0, 0, 0, 0); P1 = __builtin_amdgcn_mfma_f32_32x32x16_bf16(b1, qr[d0], P1, 0, 0, 0); } } while (0)
#define QKTN(P0, P1, b) do { const char* Ks = lds + LK + (b) * KBYTES; \
        _Pragma("unroll") for (int d0 = 0; d0 < 4; ++d0) { const int cb = (d0 * 16 + hi * 8) * 2; \
            const bf16x8 b0 = *reinterpret_cast<const bf16x8*>(Ks + KSWZ64(r32, cb)); const bf16x8 b1 = *reinterpret_cast<const bf16x8*>(Ks + KSWZ64(32 + r32, cb)); \
            if (d0 == 0) { P0 = __builtin_amdgcn_mfma_f32_32x32x16_bf16(b0, qr[0], negm, 0, 0, 0); P1 = __builtin_amdgcn_mfma_f32_32x32x16_bf16(b1, qr[0], negm, 0, 0, 0); } \
            else { P0 = __builtin_amdgcn_mfma_f32_32x32x16_bf16(b0, qr[d0], P0, 0, 0, 0); P1 = __builtin_amdgcn_mfma_f32_32x32x16_bf16(b1, qr[d0], P1, 0, 0, 0); } } } while (0)
#define PARTIAL(P0, P1, AL) do { float pmax = P0[0]; \
        _Pragma("unroll") for (int r = 1; r < 16; ++r) pmax = fmaxf(pmax, P0[r]); \
        _Pragma("unroll") for (int r = 0; r < 16; ++r) pmax = fmaxf(pmax, P1[r]); \
        { auto rr = __builtin_amdgcn_permlane32_swap(__float_as_uint(pmax), __float_as_uint(pmax), false, false); pmax = fmaxf(__uint_as_float(rr[0]), __uint_as_float(rr[1])); } \
        float mn; if (__builtin_expect(__all(pmax - m_reg <= THR), 1)) { mn = m_reg; AL = 1.f; } else { mn = fmaxf(m_reg, pmax); AL = __builtin_amdgcn_exp2f(m_reg - mn); m_reg = mn; } \
        _Pragma("unroll") for (int r = 0; r < 16; ++r) { P0[r] = __builtin_amdgcn_exp2f(P0[r] - mn); P1[r] = P1[r] - mn; } } while (0)
#define FINISH(P0, P1, AL) do { _Pragma("unroll") for (int r = 0; r < 16; ++r) P1[r] = __builtin_amdgcn_exp2f(P1[r]); \
        float ps = 0.f; _Pragma("unroll") for (int r = 0; r < 16; ++r) ps += P0[r] + P1[r]; \
        { auto rr = __builtin_amdgcn_permlane32_swap(__float_as_uint(ps), __float_as_uint(ps), false, false); ps = __uint_as_float(rr[0]) + __uint_as_float(rr[1]); } \
        l_reg = l_reg * AL + ps; bad |= !(ps < 1e30f); PK4(P0, 0, pa0); PK4(P0, 8, pa1); PK4(P1, 0, pa2); PK4(P1, 8, pa3); } while (0)
#define PVALL(b) do { const int vb = vb0 + (b) * VBYTES; pv_one<NCB, 0>(o[0], vb, pa0, pa1, pa2, pa3); pv_one<NCB, 1>(o[1], vb, pa0, pa1, pa2, pa3); \
        pv_one<NCB, 2>(o[2], vb, pa0, pa1, pa2, pa3); pv_one<NCB, 3>(o[3], vb, pa0, pa1, pa2, pa3); } while (0)
#define PV_PARTIAL(b, P0, P1, AL) do { const int vb = vb0 + (b) * VBYTES; AL = 1.f; \
        pv_one<NCB, 0>(o[0], vb, pa0, pa1, pa2, pa3); \
        _Pragma("unroll") for (int r = 0; r < 4; ++r) P0[r] = __builtin_amdgcn_exp2f(P0[r]); \
        pv_one<NCB, 1>(o[1], vb, pa0, pa1, pa2, pa3); \
        _Pragma("unroll") for (int r = 4; r < 8; ++r) P0[r] = __builtin_amdgcn_exp2f(P0[r]); \
        pv_one<NCB, 2>(o[2], vb, pa0, pa1, pa2, pa3); \
        _Pragma("unroll") for (int r = 8; r < 12; ++r) P0[r] = __builtin_amdgcn_exp2f(P0[r]); \
        pv_one<NCB, 3>(o[3], vb, pa0, pa1, pa2, pa3); \
        _Pragma("unroll") for (int r = 12; r < 16; ++r) P0[r] = __builtin_amdgcn_exp2f(P0[r]); } while (0)
#define RESC(AL) do { if (__any((AL) < 1.f)) { if (hi == 0) al_l[r32] = (AL); asm volatile("s_waitcnt lgkmcnt(0)" ::: "memory"); \
        _Pragma("unroll") for (int d = 0; d < NCB; ++d) _Pragma("unroll") for (int r = 0; r < 16; ++r) o[d][r] *= al_l[crow(r, hi)]; } } while (0)
    f32x16 pA0, pA1, pB0, pB1; float alA, alB; bf16x8 pa0, pa1, pa2, pa3; bool bad = false;
    unsigned* flagw = (unsigned*)(lds + LWS + 2048);
    if (tid == 0) *flagw = 0u;
    if (__builtin_amdgcn_readfirstlane(wid) >= 4) __builtin_amdgcn_s_setprio(1);
    SLOAD(0); SWRITE(0); __syncthreads();
    QKT(pA0, pA1, 0); PARTIAL(pA0, pA1, alA);
    f32x16 negm;
#pragma unroll
    for (int r = 0; r < 16; ++r) negm[r] = -m_reg;
    asm volatile("" : "+v"(negm));
    SLOAD(1); SWRITE(1); __syncthreads();
#pragma unroll 1
    for (int j = 1; j + 1 < NT; j += 2) {
        SBAR(); QKTN(pB0, pB1, 1);
        FINISH(pA0, pA1, alA); SBAR();
        SLOAD(j + 1); SBAR();
        PV_PARTIAL(0, pB0, pB1, alB);
        __syncthreads(); SWRITE(0);
        __syncthreads();
        SBAR(); QKTN(pA0, pA1, 0);
        FINISH(pB0, pB1, alB); SBAR();
        SLOAD(j + 2); SBAR();
        PV_PARTIAL(1, pA0, pA1, alA);
        __syncthreads(); SWRITE(1);
        __syncthreads();
    }
    SBAR(); QKTN(pB0, pB1, 1);
    FINISH(pA0, pA1, alA); SBAR();
    PV_PARTIAL(0, pB0, pB1, alB);
    FINISH(pB0, pB1, alB); SBAR();
    PVALL(1);
    __builtin_amdgcn_s_setprio(0);
    if (__any(bad) && lane == 0) *flagw = 1u;
    __syncthreads();
    const bool ok = (*flagw == 0u);
    __syncthreads();
#undef KROW
#undef SLOAD
#undef SWRITE
#undef QKT
#undef PARTIAL
#undef FINISH
#undef PVALL
#undef PV_PARTIAL
#undef RESC
#undef QKTN
    return ok;
}

template <int DV>
__device__ __forceinline__ void attn_core_sm(int wv__, char* lds, const CoreArgs& A, f32x16 (&o)[DV / 32], float& l_reg) {
    constexpr int NCB = DV / 32, VBYTES = 64 * DV * 2, KBYTES = 8192; constexpr float THR = 8.f;
    static_assert(DV == 128, "softmax core is written for 128 value columns");
    int tid = TIDX(); asm volatile("" : "+v"(tid));
    const int wid = tid >> 6, lane = tid & 63, r32 = lane & 31, hi = lane >> 5;
    float* al_l = (float*)(lds + LWS) + wid * 64;
    const int NT = A.nt_a + A.nt_b;
    bf16x8 qr[4];
    { const bf16* Qw = A.P + (size_t)(A.qrow + wid * 32 + r32) * INW + A.qcol + hi * 8;
#pragma unroll
      for (int d0 = 0; d0 < 4; ++d0) qr[d0] = *reinterpret_cast<const bf16x8*>(Qw + d0 * 16); }
#pragma unroll
    for (int d = 0; d < NCB; ++d) o[d] = f32x16{};
    float m_reg = -1e30f; l_reg = 0.f;
    const int kr = tid >> 3, kc = (tid & 7) * 8;
    const int kdst = KSWZ64(kr, kc * 2);
    const int vr0 = tid >> 4, vc0 = (tid & 15) * 8, vdst0 = v_st<NCB>(vr0, vc0), vdst1 = v_st<NCB>(vr0 + 32, vc0);
    const int vb0 = (int)(uintptr_t)(lds + LV) + v_rd_base(lane);
    bf16x8 sk, sv0, sv1;
#define KROW(t) ((t) < A.nt_a ? A.kr_a + 64 * (t) : A.kr_b + 64 * ((t) - A.nt_a))
#define SLOAD(t) do { const long kb_ = KROW(t); sk = *reinterpret_cast<const bf16x8*>(A.P + (size_t)(kb_ + kr) * INW + A.kcol + kc); \
        sv0 = *reinterpret_cast<const bf16x8*>(A.P + (size_t)(kb_ + vr0) * INW + A.vcol + vc0); \
        sv1 = *reinterpret_cast<const bf16x8*>(A.P + (size_t)(kb_ + vr0 + 32) * INW + A.vcol + vc0); } while (0)
#define SWRITE(b) do { *(bf16x8*)(lds + LK + (b) * KBYTES + kdst) = sk; *(bf16x8*)(lds + LV + (b) * VBYTES + vdst0) = sv0; \
        *(bf16x8*)(lds + LV + (b) * VBYTES + vdst1) = sv1; } while (0)
#define QKT(P0, P1, b) do { const char* Ks = lds + LK + (b) * KBYTES; P0 = f32x16{}; P1 = f32x16{}; \
        _Pragma("unroll") for (int d0 = 0; d0 < 4; ++d0) { const int cb = (d0 * 16 + hi * 8) * 2; \
            const bf16x8 b0 = *reinterpret_cast<const bf16x8*>(Ks + KSWZ64(r32, cb)); const bf16x8 b1 = *reinterpret_cast<const bf16x8*>(Ks + KSWZ64(32 + r32, cb)); \
            P0 = __builtin_amdgcn_mfma_f32_32x32x16_bf16(b0, qr[d0], P0, 0, 0, 0); P1 = __builtin_amdgcn_mfma_f32_32x32x16_bf16(b1, qr[d0], P1, 0, 0, 0); } } while (0)
#define PARTIAL(P0, P1, AL) do { float pmax = P0[0]; \
        _Pragma("unroll") for (int r = 1; r < 16; ++r) pmax = fmaxf(pmax, P0[r]); \
        _Pragma("unroll") for (int r = 0; r < 16; ++r) pmax = fmaxf(pmax, P1[r]); \
        { auto rr = __builtin_amdgcn_permlane32_swap(__float_as_uint(pmax), __float_as_uint(pmax), false, false); pmax = fmaxf(__uint_as_float(rr[0]), __uint_as_float(rr[1])); } \
        float mn; if (__builtin_expect(__all(pmax - m_reg <= THR), 1)) { mn = m_reg; AL = 1.f; } else { mn = fmaxf(m_reg, pmax); AL = __builtin_amdgcn_exp2f(m_reg - mn); m_reg = mn; } \
        _Pragma("unroll") for (int r = 0; r < 16; ++r) { P0[r] = __builtin_amdgcn_exp2f(P0[r] - mn); P1[r] = P1[r] - mn; } } while (0)
#define FINISH(P0, P1, AL) do { _Pragma("unroll") for (int r = 0; r < 16; ++r) P1[r] = __builtin_amdgcn_exp2f(P1[r]); \
        float ps = 0.f; _Pragma("unroll") for (int r = 0; r < 16; ++r) ps += P0[r] + P1[r]; \
        { auto rr = __builtin_amdgcn_permlane32_swap(__float_as_uint(ps), __float_as_uint(ps), false, false); ps = __uint_as_float(rr[0]) + __uint_as_float(rr[1]); } \
        l_reg = l_reg * AL + ps; PK4(P0, 0, pa0); PK4(P0, 8, pa1); PK4(P1, 0, pa2); PK4(P1, 8, pa3); } while (0)
#define PVALL(b) do { const int vb = vb0 + (b) * VBYTES; pv_one<NCB, 0>(o[0], vb, pa0, pa1, pa2, pa3); pv_one<NCB, 1>(o[1], vb, pa0, pa1, pa2, pa3); \
        pv_one<NCB, 2>(o[2], vb, pa0, pa1, pa2, pa3); pv_one<NCB, 3>(o[3], vb, pa0, pa1, pa2, pa3); } while (0)
#define PV_PARTIAL(b, P0, P1, AL) do { const int vb = vb0 + (b) * VBYTES; float pm0, pm1, mn; \
        pv_one<NCB, 0>(o[0], vb, pa0, pa1, pa2, pa3); \
        pm0 = fmaxf(P0[0], P0[1]); _Pragma("unroll") for (int r = 2; r < 16; ++r) pm0 = fmaxf(pm0, P0[r]); \
        pv_one<NCB, 1>(o[1], vb, pa0, pa1, pa2, pa3); \
        pm1 = fmaxf(P1[0], P1[1]); _Pragma("unroll") for (int r = 2; r < 16; ++r) pm1 = fmaxf(pm1, P1[r]); pm0 = fmaxf(pm0, pm1); \
        { auto rr = __builtin_amdgcn_permlane32_swap(__float_as_uint(pm0), __float_as_uint(pm0), false, false); pm0 = fmaxf(__uint_as_float(rr[0]), __uint_as_float(rr[1])); } \
        if (__builtin_expect(__all(pm0 - m_reg <= THR), 1)) { mn = m_reg; AL = 1.f; } else { mn = fmaxf(m_reg, pm0); AL = __builtin_amdgcn_exp2f(m_reg - mn); m_reg = mn; } \
        pv_one<NCB, 2>(o[2], vb, pa0, pa1, pa2, pa3); \
        _Pragma("unroll") for (int r = 0; r < 8; ++r) P0[r] = __builtin_amdgcn_exp2f(P0[r] - mn); \
        _Pragma("unroll") for (int r = 0; r < 16; ++r) P1[r] = P1[r] - mn; \
        pv_one<NCB, 3>(o[3], vb, pa0, pa1, pa2, pa3); \
        _Pragma("unroll") for (int r = 8; r < 16; ++r) P0[r] = __builtin_amdgcn_exp2f(P0[r] - mn); } while (0)
#define RESC(AL) do { if (__any((AL) < 1.f)) { if (hi == 0) al_l[r32] = (AL); asm volatile("s_waitcnt lgkmcnt(0)" ::: "memory"); \
        _Pragma("unroll") for (int d = 0; d < NCB; ++d) _Pragma("unroll") for (int r = 0; r < 16; ++r) o[d][r] *= al_l[crow(r, hi)]; } } while (0)
    f32x16 pA0, pA1, pB0, pB1; float alA, alB; bf16x8 pa0, pa1, pa2, pa3;
    SLOAD(0); SWRITE(0); __syncthreads();
    QKT(pA0, pA1, 0); PARTIAL(pA0, pA1, alA);
    SLOAD(1); SWRITE(1); __syncthreads();
#pragma unroll 1
    for (int j = 1; j + 1 < NT; j += 2) {
        SBAR(); QKT(pB0, pB1, 1);
        FINISH(pA0, pA1, alA); SBAR();
        SLOAD(j + 1); SBAR();
        PV_PARTIAL(0, pB0, pB1, alB);
        __syncthreads(); SWRITE(0);
        RESC(alB); __syncthreads();
        SBAR(); QKT(pA0, pA1, 0);
        FINISH(pB0, pB1, alB); SBAR();
        SLOAD(j + 2); SBAR();
        PV_PARTIAL(1, pA0, pA1, alA);
        __syncthreads(); SWRITE(1);
        RESC(alA); __syncthreads();
    }
    SBAR(); QKT(pB0, pB1, 1);
    FINISH(pA0, pA1, alA); SBAR();
    PV_PARTIAL(0, pB0, pB1, alB);
    RESC(alB);
    FINISH(pB0, pB1, alB); SBAR();
    PVALL(1);
    __syncthreads();
#undef KROW
#undef SLOAD
#undef SWRITE
#undef QKT
#undef PARTIAL
#undef FINISH
#undef PVALL
#undef PV_PARTIAL
#undef RESC
}
__device__ __forceinline__ void diff_unit(int wv__, char* lds, const bf16* P, bf16* MIX, float* scr  , const float* gnw  ,
                                          float lam, float lam_init, long qrow, long kr_a, int nt_a, long kr_b, int nt_b, int h) {
    int tid = TIDX(); asm volatile("" : "+v"(tid));
    const int wid = tid >> 6, lane = tid & 63, r32 = lane & 31, hi = lane >> 5;
    float* al_l = (float*)(lds + LWS) + wid * 64;
    CoreArgs A; A.P = P; A.qrow = qrow; A.vcol = 2048 + 128 * h;
    A.kr_a = kr_a; A.nt_a = nt_a; A.kr_b = kr_b; A.nt_b = nt_b; A.ipos0 = 0; A.lf = 0.f; A.lb = 0.f;
    {
        A.qcol = 1024 + 64 * (2 * h); A.kcol = 1536 + 64 * (2 * h);
        f32x16 o[4]; float l_reg;
        if (!attn_core_fast<128>(wv__, lds, A, o, l_reg)) attn_core_sm<128>(wv__, lds, A, o, l_reg);
        if (hi == 0) al_l[r32] = l_reg; asm volatile("s_waitcnt lgkmcnt(0)" ::: "memory");
        f32x4* sp = (f32x4*)scr + (size_t)(wid * 1024 + lane);
#pragma unroll
        for (int r = 0; r < 16; ++r) { const float rl = __builtin_amdgcn_rcpf(al_l[crow(r, hi)]);
            sp[r * 64] = (f32x4){o[0][r] * rl, o[1][r] * rl, o[2][r] * rl, o[3][r] * rl}; }
        __syncthreads();
    }
    {
        A.qcol = 1024 + 64 * (2 * h + 1); A.kcol = 1536 + 64 * (2 * h + 1);
        f32x16 o[4]; float l_reg;
        if (!attn_core_fast<128>(wv__, lds, A, o, l_reg)) attn_core_sm<128>(wv__, lds, A, o, l_reg);
        if (hi == 0) al_l[r32] = l_reg; asm volatile("s_waitcnt lgkmcnt(0)" ::: "memory");
        const f32x4* sp = (const f32x4*)scr + (size_t)(wid * 1024 + lane);
        float w4[4];
#pragma unroll
        for (int d = 0; d < 4; ++d) w4[d] = gnw[h * 128 + 32 * d + r32] * (1.f - lam_init);
        f32x4 s0a[16];
#pragma unroll
        for (int r = 0; r < 16; ++r) s0a[r] = sp[r * 64];
#pragma unroll
        for (int r = 0; r < 16; ++r) {
            const float rl = lam * __builtin_amdgcn_rcpf(al_l[crow(r, hi)]);
            float v[4]; float ss = 0.f; const f32x4 s0 = s0a[r];
#pragma unroll
            for (int d = 0; d < 4; ++d) { v[d] = s0[d] - o[d][r] * rl; ss += v[d] * v[d]; }
            const float rs = __builtin_amdgcn_rsqf(half_sum32(ss) * (1.f / 128.f) + EPSN);
            bf16* mp = MIX + (size_t)(qrow + wid * 32 + crow(r, hi)) * DM + 256 + h * 128 + r32;
#pragma unroll
            for (int d = 0; d < 4; ++d) mp[32 * d] = (bf16)f2bf(v[d] * rs * w4[d]);
            if ((r & 1) == 1) asm volatile("" ::: "memory");
        }
        __syncthreads();
    }
}
__device__ __forceinline__ void ret_epilogue(f32x16 (&o)[2], const bf16* P, bf16* MIX, const float* gnw, long qrow, int wid, int r32, int hi, int h) {
    unsigned short gq[2][16];
#pragma unroll
    for (int d = 0; d < 2; ++d)
#pragma unroll
        for (int r = 0; r < 16; ++r) gq[d][r] = P[(size_t)(qrow + wid * 32 + crow(r, hi)) * INW + 768 + 64 * h + 32 * d + r32];
    float mu[16], rs[16];
#pragma unroll
    for (int r = 0; r < 16; ++r) mu[r] = half_sum32(o[0][r] + o[1][r]) * (1.f / 64.f);
#pragma unroll
    for (int r = 0; r < 16; ++r) { const float a = o[0][r] - mu[r], b = o[1][r] - mu[r]; o[0][r] = a; o[1][r] = b; rs[r] = __builtin_amdgcn_rsqf(half_sum32(a * a + b * b) * (1.f / 64.f) + EPSN); }
#pragma unroll
    for (int d = 0; d < 2; ++d) { const float w = gnw[h * 64 + 32 * d + r32];
#pragma unroll
        for (int r = 0; r < 16; ++r) { const size_t row = (size_t)(qrow + wid * 32 + crow(r, hi));
            const float g = bf2f(gq[d][r]);
            MIX[row * DM + 64 * h + 32 * d + r32] = (bf16)f2bf(o[d][r] * rs[r] * w * g); } }
}
template <int KS> __device__ __forceinline__ bf16x8 tr_frag(int base) {
    const s16x4 l = tr_read<KS * 2048>(base), hh = tr_read<KS * 2048 + 1024>(base);
    return (bf16x8){l[0], l[1], l[2], l[3], hh[0], hh[1], hh[2], hh[3]};
}
__device__ __forceinline__ bf16x8 scale8(bf16x8 v, float c) {
    const v4u u = __builtin_bit_cast(v4u, v); v4u o;
    o.x = pk2(__uint_as_float(u.x << 16) * c, __uint_as_float(u.x & 0xffff0000u) * c); o.y = pk2(__uint_as_float(u.y << 16) * c, __uint_as_float(u.y & 0xffff0000u) * c);
    o.z = pk2(__uint_as_float(u.z << 16) * c, __uint_as_float(u.z & 0xffff0000u) * c); o.w = pk2(__uint_as_float(u.w << 16) * c, __uint_as_float(u.w & 0xffff0000u) * c);
    return __builtin_bit_cast(bf16x8, o);
}
__device__ __forceinline__ void ret_unit_state(int wv__, char* lds, const bf16* P, bf16* MIX, const float* gnw, float lf, float lb, int b, int blk, int h) {
    int tid = TIDX(); asm volatile("" : "+v"(tid));
    const int wid = tid >> 6, lane = tid & 63, r32 = lane & 31, hi = lane >> 5;
    const int i0 = blk * 256; const long qrow = (long)b * SEQ + i0;
    const int kcol = 256 + 64 * h, vcol = 512 + 64 * h;
    constexpr int STG = 49152, OVF = 16384, OVB = 32768;
    constexpr int LSF = 98304, LSB = 106496, LRED = 114688;
    const int srow = tid >> 3, sc8 = (tid & 7) * 8;
    const int sdst = v_st<2>(srow, sc8);
    const int d0 = wid & 1, n0 = (wid >> 1) & 1, kh = wid >> 2;
    const int vbase = (int)(uintptr_t)lds + v_rd_base(lane);
    f32x16 accf = f32x16{}, accb = f32x16{};
    bf16x8 rk0, rk1, rv0, rv1; float cf0, cb0, cf1, cb1;
#define FAR_LOAD(s) do { long kb_; int j_; const bool ctx_ = (s) >= 14; \
        if (!ctx_) { const int pp = (s) < 2 * blk ? (s) : (s) + 2; kb_ = (long)b * SEQ + 128 * pp; j_ = 128 * pp; } else { kb_ = (long)NLAT + (long)b * CTXL + 128 * ((s) - 14); j_ = 128 * ((s) - 14); } \
        const bf16* r0_ = P + (size_t)(kb_ + srow) * INW; const bf16* r1_ = r0_ + (size_t)64 * INW; \
        rk0 = *(const bf16x8*)(r0_ + kcol + sc8); rv0 = *(const bf16x8*)(r0_ + vcol + sc8); rk1 = *(const bf16x8*)(r1_ + kcol + sc8); rv1 = *(const bf16x8*)(r1_ + vcol + sc8); \
        const int ja = j_ + srow, jb = ja + 64; \
        if (ctx_) { cf0 = __builtin_amdgcn_exp2f(lf * (float)(i0 + CTXL - ja)); cb0 = __builtin_amdgcn_exp2f(lb * (float)(SEQ + ja - i0 - 255)); \
                    cf1 = __builtin_amdgcn_exp2f(lf * (float)(i0 + CTXL - jb)); cb1 = __builtin_amdgcn_exp2f(lb * (float)(SEQ + jb - i0 - 255)); } \
        else { const bool bel = ja < i0; cf0 = bel ? __builtin_amdgcn_exp2f(lf * (float)(i0 - ja)) : 0.f; cb0 = bel ? 0.f : __builtin_amdgcn_exp2f(lb * (float)(ja - i0 - 255)); \
               cf1 = bel ? __builtin_amdgcn_exp2f(lf * (float)(i0 - jb)) : 0.f; cb1 = bel ? 0.f : __builtin_amdgcn_exp2f(lb * (float)(jb - i0 - 255)); } } while (0)
#define FAR_WRITE(bf) do { char* sb_ = lds + (bf) * STG + sdst; \
        *(bf16x8*)(sb_) = rk0; *(bf16x8*)(sb_ + 8192) = rk1; \
        *(bf16x8*)(sb_ + OVF) = scale8(rv0, cf0); *(bf16x8*)(sb_ + OVF + 8192) = scale8(rv1, cf1); \
        *(bf16x8*)(sb_ + OVB) = scale8(rv0, cb0); *(bf16x8*)(sb_ + OVB + 8192) = scale8(rv1, cb1); } while (0)
#define FAR_STEP(KS) do { const bf16x8 a_ = tr_frag<KS>(ka_), f_ = tr_frag<KS>(fa_), g_ = tr_frag<KS>(ga_); asm volatile("s_waitcnt lgkmcnt(0)" ::: "memory"); SBAR(); \
        accf = __builtin_amdgcn_mfma_f32_32x32x16_bf16(a_, f_, accf, 0, 0, 0); accb = __builtin_amdgcn_mfma_f32_32x32x16_bf16(a_, g_, accb, 0, 0, 0); } while (0)
    FAR_LOAD(0); FAR_WRITE(0); __syncthreads();
#pragma unroll 1
    for (int s = 0; s < 16; ++s) {
        const int buf = s & 1;
        if (s + 1 < 16) FAR_LOAD(s + 1);
        { const int ka_ = vbase + buf * STG + kh * 8192 + d0 * 512, fa_ = vbase + buf * STG + OVF + kh * 8192 + n0 * 512, ga_ = vbase + buf * STG + OVB + kh * 8192 + n0 * 512;
          FAR_STEP(0); FAR_STEP(1); FAR_STEP(2); FAR_STEP(3); }
        if (s + 1 < 16) FAR_WRITE(buf ^ 1);
        __syncthreads();
    }
#undef FAR_LOAD
#undef FAR_WRITE
#undef FAR_STEP
    { float* red = (float*)(lds + LRED);
      if (wid >= 4) {
#pragma unroll
          for (int r = 0; r < 16; ++r) { red[((wid - 4) * 2 + 0) * 1024 + r * 64 + lane] = accf[r]; red[((wid - 4) * 2 + 1) * 1024 + r * 64 + lane] = accb[r]; } }
      __syncthreads();
      if (wid < 4) {
#pragma unroll
          for (int r = 0; r < 16; ++r) { const float sf = accf[r] + red[(wid * 2 + 0) * 1024 + r * 64 + lane], sb = accb[r] + red[(wid * 2 + 1) * 1024 + r * 64 + lane];
              const int off = v_st<2>(32 * d0 + crow(r, hi), 32 * n0 + r32);
              *(bf16*)(lds + LSF + off) = (bf16)f2bf(sf); *(bf16*)(lds + LSB + off) = (bf16)f2bf(sb); } }
      __syncthreads(); }
    CoreArgs A; A.P = P; A.qrow = qrow; A.qcol = 64 * h; A.kcol = kcol; A.vcol = vcol;
    A.kr_a = qrow; A.nt_a = 4; A.kr_b = 0; A.nt_b = 0; A.ipos0 = 0; A.lf = lf; A.lb = lb;
    f32x16 o[2]; float l_reg;
    attn_core<64, 1>(wv__, lds, A, o, l_reg);
    { const int iqr = wid * 32 + r32;
      const bf16* Qp = P + (size_t)(qrow + iqr) * INW + 64 * h + 4 * hi;
      float x0[16], x1[16];
#pragma unroll
      for (int g = 0; g < 4; ++g) { const v2u a = *(const v2u*)(Qp + 8 * g), c = *(const v2u*)(Qp + 32 + 8 * g);
          x0[4 * g + 0] = __uint_as_float(a.x << 16); x0[4 * g + 1] = __uint_as_float(a.x & 0xffff0000u); x0[4 * g + 2] = __uint_as_float(a.y << 16); x0[4 * g + 3] = __uint_as_float(a.y & 0xffff0000u);
          x1[4 * g + 0] = __uint_as_float(c.x << 16); x1[4 * g + 1] = __uint_as_float(c.x & 0xffff0000u); x1[4 * g + 2] = __uint_as_float(c.y << 16); x1[4 * g + 3] = __uint_as_float(c.y & 0xffff0000u); }
      const float af = __builtin_amdgcn_exp2f(lf * (float)iqr), ab = __builtin_amdgcn_exp2f(lb * (float)(255 - iqr));
      float y0[16], y1[16]; bf16x8 pa0, pa1, pa2, pa3;
#pragma unroll
      for (int r = 0; r < 16; ++r) { y0[r] = x0[r] * af; y1[r] = x1[r] * af; }
      PK4(y0, 0, pa0); PK4(y0, 8, pa1); PK4(y1, 0, pa2); PK4(y1, 8, pa3); SBAR();
      pv_one<2, 0>(o[0], vbase + LSF, pa0, pa1, pa2, pa3); pv_one<2, 1>(o[1], vbase + LSF, pa0, pa1, pa2, pa3);
#pragma unroll
      for (int r = 0; r < 16; ++r) { y0[r] = x0[r] * ab; y1[r] = x1[r] * ab; }
      PK4(y0, 0, pa0); PK4(y0, 8, pa1); PK4(y1, 0, pa2); PK4(y1, 8, pa3); SBAR();
      pv_one<2, 0>(o[0], vbase + LSB, pa0, pa1, pa2, pa3); pv_one<2, 1>(o[1], vbase + LSB, pa0, pa1, pa2, pa3); }
    ret_epilogue(o, P, MIX, gnw, qrow, wid, r32, hi, h);
    __syncthreads();
}
__device__ __forceinline__ void ret_unit(int wv__, char* lds, const bf16* P, bf16* MIX, const float* gnw  , float lf, float lb,
                                         long qrow, int ipos0, long kr_a, int nt_a, long kr_b, int nt_b, int h) {
    int tid = TIDX(); asm volatile("" : "+v"(tid));
    const int wid = tid >> 6, lane = tid & 63, r32 = lane & 31, hi = lane >> 5;
    CoreArgs A; A.P = P; A.qrow = qrow; A.qcol = 64 * h; A.kcol = 256 + 64 * h; A.vcol = 512 + 64 * h;
    A.kr_a = kr_a; A.nt_a = nt_a; A.kr_b = kr_b; A.nt_b = nt_b; A.ipos0 = ipos0; A.lf = lf; A.lb = lb;
    f32x16 o[2]; float l_reg;
    attn_core<64, 1>(wv__, lds, A, o, l_reg);
    ret_epilogue(o, P, MIX, gnw, qrow, wid, r32, hi, h);
    __syncthreads();
}
#undef SBAR
}

__device__ __forceinline__ void conv_unit(int wv__, char* lds, const bf16* P, bf16* MIX, const float* cw  , const float* cb, const float* lnw, const float* lnb,
                                          long seqrow  , int L, int t0) {
    int tid = TIDX(); asm volatile("" : "+v"(tid));
    const int wid = tid >> 6, lane = tid & 63;
    bf16* ub = (bf16*)lds;
    float* yb = (float*)(lds + 49152);
    for (int i = tid; i < 94 * 32; i += 512) { const int rr = i >> 5, ch = (i & 31) * 8; const int t = t0 - 15 + rr;
        v4u v = {0u, 0u, 0u, 0u};
        if (t >= 0 && t < L) v = *(const v4u*)(P + (size_t)(seqrow + t) * INW + 2560 + ch);
        *(v4u*)(ub + rr * 256 + ch) = v; }
    __syncthreads();
    { const int c = tid & 255, hf = tid >> 8;
      float w[31];
#pragma unroll
      for (int k = 0; k < 31; ++k) w[k] = cw[k * 256 + c];
      const float bias = cb[c];
#pragma unroll
      for (int g = 0; g < 4; ++g) {
          float uv[38];
#pragma unroll
          for (int k = 0; k < 38; ++k) uv[k] = bf2f(ub[(hf * 32 + g * 8 + k) * 256 + c]);
#pragma unroll
          for (int tt = 0; tt < 8; ++tt) { float a = bias;
#pragma unroll
              for (int k = 0; k < 31; ++k) a += uv[tt + k] * w[k];
              yb[(hf * 32 + g * 8 + tt) * 256 + c] = a; }
      } }
    __syncthreads();
    { const f32x4 lw = *(const f32x4*)(lnw + lane * 4), lb = *(const f32x4*)(lnb + lane * 4);
#pragma unroll 1
      for (int i = 0; i < 8; ++i) { const int tok = wid * 8 + i;
        f32x4 v = *(const f32x4*)(yb + tok * 256 + lane * 4);
        const float mean = wave_sum((v.x + v.y) + (v.z + v.w)) * (1.f / 256.f);
        v = v - mean;
        const float rstd = __builtin_amdgcn_rsqf(wave_sum((v.x * v.x + v.y * v.y) + (v.z * v.z + v.w * v.w)) * (1.f / 256.f) + EPSN);
        v = v * rstd * lw + lb;
        v.x *= fast_sigmoid(v.x); v.y *= fast_sigmoid(v.y); v.z *= fast_sigmoid(v.z); v.w *= fast_sigmoid(v.w);
        v2u o; o.x = pk2(v.x, v.y); o.y = pk2(v.z, v.w);
        *(v2u*)(MIX + (size_t)(seqrow + t0 + tok) * DM + 768 + lane * 4) = o; } }
    __syncthreads();
}

__device__ __forceinline__ void norm_mod_rows(int wv__, const float* xl, const float* xc, const float* w, const float* modl, int si, int sci, bf16* XN, int nrows, int vcu, int NGW) {
    int tid_ = TIDX(); asm volatile("" : "+v"(tid_)); const int lane = tid_ & 63, gw = vcu * 8 + __builtin_amdgcn_readfirstlane(tid_ >> 6);
    f32x4 wv[4];
#pragma unroll
    for (int j = 0; j < 4; ++j) wv[j] = *(const f32x4*)(w + 256 * j + 4 * lane);
    for (int row0 = gw; row0 < nrows; row0 += 2 * NGW) {
        const int row1 = row0 + NGW; const bool has1 = row1 < nrows; const int r1 = has1 ? row1 : row0;
        const bool lat0 = row0 < NLAT, lat1 = r1 < NLAT;
        const float* x0 = lat0 ? xl + (size_t)row0 * DM : xc + (size_t)(row0 - NLAT) * DM;
        const float* x1 = lat1 ? xl + (size_t)r1 * DM : xc + (size_t)(r1 - NLAT) * DM;
        const float* mb0 = modl + (size_t)(lat0 ? (row0 >> 11) : 16) * NMODW; const float* mb1 = modl + (size_t)(lat1 ? (r1 >> 11) : 16) * NMODW;
        f32x4 v0[4], v1[4]; float s0 = 0.f, s1 = 0.f;
#pragma unroll
        for (int j = 0; j < 4; ++j) { v0[j] = __builtin_nontemporal_load((const f32x4*)(x0 + 256 * j + 4 * lane)); v1[j] = __builtin_nontemporal_load((const f32x4*)(x1 + 256 * j + 4 * lane)); }
#pragma unroll
        for (int j = 0; j < 4; ++j) { s0 += (v0[j].x * v0[j].x + v0[j].y * v0[j].y) + (v0[j].z * v0[j].z + v0[j].w * v0[j].w); s1 += (v1[j].x * v1[j].x + v1[j].y * v1[j].y) + (v1[j].z * v1[j].z + v1[j].w * v1[j].w); }
#pragma unroll
        for (int o = 1; o < 64; o <<= 1) { s0 += __shfl_xor(s0, o); s1 += __shfl_xor(s1, o); }
        const float rs0 = __builtin_amdgcn_rsqf(s0 * (1.f / DM) + EPSN), rs1 = __builtin_amdgcn_rsqf(s1 * (1.f / DM) + EPSN);
#pragma unroll
        for (int j = 0; j < 4; ++j) { const int c = 256 * j + 4 * lane;
            { const f32x4 y = v0[j] * rs0 * wv[j] * (*(const f32x4*)(mb0 + sci * DM + c) + 1.f) + *(const f32x4*)(mb0 + si * DM + c);
              v2u o; o.x = pk2(y.x, y.y); o.y = pk2(y.z, y.w); *(v2u*)(XN + (size_t)row0 * DM + c) = o; }
            if (has1) { const f32x4 y = v1[j] * rs1 * wv[j] * (*(const f32x4*)(mb1 + sci * DM + c) + 1.f) + *(const f32x4*)(mb1 + si * DM + c);
              v2u o; o.x = pk2(y.x, y.y); o.y = pk2(y.z, y.w); *(v2u*)(XN + (size_t)row1 * DM + c) = o; } }
    }
}
__device__ __forceinline__ void final_norm_rows(int wv__, float* x, const float* w, int vcu, int NGW) {
    int tid_ = TIDX(); asm volatile("" : "+v"(tid_)); const int lane = tid_ & 63, gw = vcu * 8 + __builtin_amdgcn_readfirstlane(tid_ >> 6);
    f32x4 wv[4];
#pragma unroll
    for (int j = 0; j < 4; ++j) wv[j] = *(const f32x4*)(w + 256 * j + 4 * lane);
    for (int row = gw; row < NLAT; row += 2 * NGW) {
        float* x0 = x + (size_t)row * DM; float* x1 = x + (size_t)(row + NGW) * DM; f32x4 v0[4], v1[4]; float s0 = 0.f, s1 = 0.f;
#pragma unroll
        for (int j = 0; j < 4; ++j) { v0[j] = *(const f32x4*)(x0 + 256 * j + 4 * lane); v1[j] = *(const f32x4*)(x1 + 256 * j + 4 * lane); }
#pragma unroll
        for (int j = 0; j < 4; ++j) { s0 += (v0[j].x * v0[j].x + v0[j].y * v0[j].y) + (v0[j].z * v0[j].z + v0[j].w * v0[j].w); s1 += (v1[j].x * v1[j].x + v1[j].y * v1[j].y) + (v1[j].z * v1[j].z + v1[j].w * v1[j].w); }
#pragma unroll
        for (int o = 1; o < 64; o <<= 1) { s0 += __shfl_xor(s0, o); s1 += __shfl_xor(s1, o); }
        const float rs0 = __builtin_amdgcn_rsqf(s0 * (1.f / DM) + EPSN), rs1 = __builtin_amdgcn_rsqf(s1 * (1.f / DM) + EPSN);
#pragma unroll
        for (int j = 0; j < 4; ++j) { *(f32x4*)(x0 + 256 * j + 4 * lane) = v0[j] * rs0 * wv[j]; *(f32x4*)(x1 + 256 * j + 4 * lane) = v1[j] * rs1 * wv[j]; }
    }
}
__device__ __forceinline__ void ctx_combine(int wv__, float* CTXRES, const float* part0, const float* part1, const float* gate, const float* nw, const float* sc, bf16* XNc, float* rowsqc, int vcu, int NGW) {
    int tid_ = TIDX(); asm volatile("" : "+v"(tid_)); const int lane = tid_ & 63, gw = vcu * 8 + __builtin_amdgcn_readfirstlane(tid_ >> 6);
    f32x4 gv[4], mv[4];
#pragma unroll
    for (int j = 0; j < 4; ++j) { const int c = 256 * j + 4 * lane; gv[j] = *(const f32x4*)(gate + c); mv[j] = *(const f32x4*)(nw + c) * (*(const f32x4*)(sc + c) + 1.f); }
    for (int row = gw; row < NCTX; row += NGW) {
        f32x4 a0[4], a1[4], a2[4], a3[4], cr[4];
#pragma unroll
        for (int j = 0; j < 4; ++j) { const size_t off = (size_t)row * DM + 256 * j + 4 * lane;
            a0[j] = *(const f32x4*)(part0 + off); a1[j] = *(const f32x4*)(part0 + (size_t)NCTX * DM + off); a2[j] = *(const f32x4*)(part1 + off); a3[j] = *(const f32x4*)(part1 + (size_t)NCTX * DM + off);
            cr[j] = *(const f32x4*)(CTXRES + off); }
        float ss = 0.f;
#pragma unroll
        for (int j = 0; j < 4; ++j) { const size_t off = (size_t)row * DM + 256 * j + 4 * lane;
            const f32x4 x = cr[j] + gv[j] * ((a0[j] + a1[j]) + (a2[j] + a3[j]));
            *(f32x4*)(CTXRES + off) = x; ss += (x.x * x.x + x.y * x.y) + (x.z * x.z + x.w * x.w);
            const f32x4 y = x * mv[j];
            v2u o; o.x = pk2(y.x, y.y); o.y = pk2(y.z, y.w); *(v2u*)(XNc + off) = o; }
        ss = wave_sum(ss);
        if (lane == 0) rowsqc[row] = ss;
    }
}
template <bool PERMIN>
__device__ __forceinline__ void p0_transpose_item(const float* W, int K, int N, bf16* WT, LAS float* scr, int item, int lane) {
    const int nblk = N / 32, kb = item / nblk, nb = item % nblk, k0 = 64 * kb, n0 = 32 * nb;
    const int src = PERMIN ? win_src_col(n0 + (lane & 31)) : n0 + (lane & 31);
    { float t[32];
#pragma unroll
      for (int i = 0; i < 32; ++i) t[i] = __builtin_nontemporal_load(W + (size_t)(k0 + 2 * i + (lane >> 5)) * N + src);
#pragma unroll
      for (int i = 0; i < 32; ++i) scr[(2 * i + (lane >> 5)) * 33 + (lane & 31)] = t[i]; }
    asm volatile("s_waitcnt lgkmcnt(0)" ::: "memory");
    const int c = lane & 7;
#pragma unroll
    for (int j = 0; j < 4; ++j) { const int n = (lane >> 3) + 8 * j; const LAS float* s = scr + (8 * c) * 33 + n;
        v4u o; o.x = pk2(s[0 * 33], s[1 * 33]); o.y = pk2(s[2 * 33], s[3 * 33]); o.z = pk2(s[4 * 33], s[5 * 33]); o.w = pk2(s[6 * 33], s[7 * 33]);
        *(v4u*)(WT + (size_t)(n0 + n) * K + k0 + 8 * c) = o; }
    asm volatile("s_waitcnt lgkmcnt(0)" ::: "memory");
}
__device__ __forceinline__ void mod_unit(int wv__, char* lds, const float* c, const float* cctx, const float* adaw, const float* adab, float* MOD, int l, int nb) {
    int tid = TIDX(); asm volatile("" : "+v"(tid));
    const int wid = tid >> 6, lane = tid & 63;
    float* sil = (float*)lds;
    float* red = (float*)(lds + 69632);
    { float t[34];
#pragma unroll
      for (int j = 0; j < 34; ++j) { const int i = tid + 512 * j, r = i >> 10, k = i & 1023; t[j] = (r < 16) ? c[r * 1024 + k] : cctx[k]; }
#pragma unroll
      for (int j = 0; j < 34; ++j) sil[tid + 512 * j] = t[j] * fast_sigmoid(t[j]); }
    __syncthreads();
    const int n0 = nb * 64;
    const float* wp = adaw + (size_t)l * DM * NMODW + n0 + lane;
    float acc[17];
#pragma unroll
    for (int r = 0; r < 17; ++r) acc[r] = 0.f;
#pragma unroll 1
    for (int kb = 0; kb < 128; kb += 32) {
        float wv[32];
#pragma unroll
        for (int j = 0; j < 32; ++j) wv[j] = __builtin_nontemporal_load(wp + (size_t)(wid * 128 + kb + j) * NMODW);
#pragma unroll
        for (int j = 0; j < 32; ++j) { const int k = wid * 128 + kb + j;
#pragma unroll
            for (int r = 0; r < 17; ++r) acc[r] += sil[r * 1024 + k] * wv[j]; } }
#pragma unroll
    for (int r = 0; r < 17; ++r) red[(wid * 17 + r) * 64 + lane] = acc[r];
    __syncthreads();
    for (int i = tid; i < 17 * 64; i += 512) { const int r = i >> 6, n = i & 63; float s = adab[(size_t)l * NMODW + n0 + n];
#pragma unroll
        for (int w = 0; w < 8; ++w) s += red[(w * 17 + r) * 64 + n];
        MOD[((size_t)l * 17 + r) * NMODW + n0 + n] = s; }
    __syncthreads();
}

__device__ __forceinline__ void shift_gemv(int wv__, char* lds, const float* modbase, int idx, const bf16* WT, float* S, int N, int vcu, int NGW) {
    int tid = TIDX(); asm volatile("" : "+v"(tid));
    const int lane = tid & 63, gw = vcu * 8 + __builtin_amdgcn_readfirstlane(tid >> 6);
    float* sh = (float*)lds;
    { float t[34];
#pragma unroll
      for (int j = 0; j < 34; ++j) { const int i = tid + 512 * j; t[j] = modbase[(size_t)(i >> 10) * NMODW + idx * DM + (i & 1023)]; }
#pragma unroll
      for (int j = 0; j < 34; ++j) sh[tid + 512 * j] = t[j]; }
    __syncthreads();
    v4u r0 = {0u, 0u, 0u, 0u}, r1 = {0u, 0u, 0u, 0u};
    if (gw < N) { const bf16* wrow = WT + (size_t)gw * DM + 8 * lane; r0 = *(const v4u*)wrow; r1 = *(const v4u*)(wrow + 512); }
    for (int p = gw; p < N; p += NGW) {
        float w[16];
        w[0] = __uint_as_float(r0.x << 16); w[1] = __uint_as_float(r0.x & 0xffff0000u); w[2] = __uint_as_float(r0.y << 16); w[3] = __uint_as_float(r0.y & 0xffff0000u);
        w[4] = __uint_as_float(r0.z << 16); w[5] = __uint_as_float(r0.z & 0xffff0000u); w[6] = __uint_as_float(r0.w << 16); w[7] = __uint_as_float(r0.w & 0xffff0000u);
        w[8] = __uint_as_float(r1.x << 16); w[9] = __uint_as_float(r1.x & 0xffff0000u); w[10] = __uint_as_float(r1.y << 16); w[11] = __uint_as_float(r1.y & 0xffff0000u);
        w[12] = __uint_as_float(r1.z << 16); w[13] = __uint_as_float(r1.z & 0xffff0000u); w[14] = __uint_as_float(r1.w << 16); w[15] = __uint_as_float(r1.w & 0xffff0000u);
        if (p + NGW < N) { const bf16* wn = WT + (size_t)(p + NGW) * DM + 8 * lane; r0 = *(const v4u*)wn; r1 = *(const v4u*)(wn + 512); }
#pragma unroll 1
        for (int b = 0; b < 17; ++b) { const float* s = sh + b * 1024 + 8 * lane; float a = 0.f;
#pragma unroll
            for (int i = 0; i < 8; ++i) a += w[i] * s[i] + w[8 + i] * s[512 + i];
            a = wave_sum(a);
            if (lane == 0) S[(size_t)b * N + p] = a; }
    }
    __syncthreads();
}

struct Args { const float* in[21]; float* out; unsigned char* ws; int ph_lo, ph_hi, coop, pad; };
constexpr int NPHASE = 13;

__global__ void __launch_bounds__(512, 2) mega_fwd(Args args) {
    extern __shared__ __attribute__((aligned(16))) unsigned char lds[];
    cg::grid_group grid = cg::this_grid();
    constexpr int G = 256; const int bx = blockIdx.x & 255;
    const int vcu = (bx % 8) * (G / 8) + bx / 8;
    const int NGW = G * 8;
    unsigned char* ws = args.ws;
    const float* x_in = args.in[0]; const float* c_in = args.in[1]; const float* ctx_in = args.in[2]; const float* cctx_in = args.in[3];
    const float* norm1_w = args.in[4]; const float* norm2_w = args.in[5]; const float* ada_w = args.in[6]; const float* ada_b = args.in[7];
    const float* w_in = args.in[8]; const float* ret_ld = args.in[9]; const float* ret_gn = args.in[10]; const float* dlam = args.in[11];
    const float* diff_gn = args.in[12]; const float* conv_w = args.in[13]; const float* conv_b = args.in[14]; const float* conv_lnw = args.in[15];
    const float* conv_lnb = args.in[16]; const float* w_out = args.in[17]; const float* mlp_w1 = args.in[18]; const float* mlp_w2 = args.in[19];
    const float* final_w = args.in[20];
    float* out = args.out;
    bf16* WinT = (bf16*)(ws + WS_WIN); bf16* WoutT = (bf16*)(ws + WS_WOUT); bf16* W1T = (bf16*)(ws + WS_W1); bf16* W2T = (bf16*)(ws + WS_W2);
    float* MOD = (float*)(ws + WS_MOD); float* SCAL = (float*)(ws + WS_SCAL); float* CTXRES = (float*)(ws + WS_CTXRES);
    float* SCR = (float*)(ws + WS_SCR) + (size_t)bx * (256 * 128);
    float* RSQ = (float*)(ws + WS_RSQ); float* S_UP = (float*)(ws + WS_SB); float* S_IN1 = (float*)(ws + WS_SB + MiB);
    bf16* XN = (bf16*)(ws + WS_XN); bf16* P = (bf16*)(ws + WS_P); bf16* MIX = (bf16*)(ws + WS_MIX); bf16* H = (bf16*)(ws + WS_H);
    volatile LAS unsigned* MISC = (volatile LAS unsigned*)((LAS unsigned char*)lds + 147456 + 64);
    const int wv__ = __builtin_amdgcn_readfirstlane(threadIdx.x >> 6);
    if (threadIdx.x < 4) MISC[threadIdx.x] = 0u;
    __syncthreads();
    XcdBarrier xbar; xbar.bar = (unsigned*)(ws + WS_CTL); xbar.x = 0; xbar.st = nullptr;
    xbar = xcd_barrier_post(wv__, (unsigned*)(ws + WS_CTL), MISC);
    if (args.coop == 2) grid.sync();
#define IN(k) true
#define SEAM(k) do { { { XcdBarrier xb_ = xbar; asm volatile("" : "+s"(xb_.bar), "+s"(xb_.x)); xcd_barrier(wv__, xb_); } } } while (0)

    if (IN(0)) {
        int tid = TIDX(); asm volatile("" : "+v"(tid)); const int lane = tid & 63, wave = __builtin_amdgcn_readfirstlane(tid >> 6), gw = vcu * 8 + wave;
        if (vcu < 192) mod_unit(wv__, (char*)lds, c_in, cctx_in, ada_w, ada_b, MOD, vcu / 96, vcu % 96);
        if (vcu == 255 && wave == 0) {
            for (int l = 0; l < 2; ++l) { const float* d = dlam + l * 256;
                const float sa = wave_sum(d[lane] * d[64 + lane]), sb = wave_sum(d[128 + lane] * d[192 + lane]);
                const float lam_init = (l == 0) ? 0.2f : (0.8f - 0.6f * 0.7408182206817179f);
                if (lane == 0) { SCAL[2 * l] = __expf(sa) - __expf(sb) + lam_init; SCAL[2 * l + 1] = lam_init; } }
        }
        __syncthreads();
        LAS float* scr = (LAS float*)((LAS unsigned char*)lds + wave * 16384);
        constexpr int I_IN = 16 * 96, I_OUT = 16 * 32, I_1 = 16 * 128, I_2 = 64 * 32, I_L = I_IN + I_OUT + I_1 + I_2;
        for (int it = gw; it < 2 * I_L; it += NGW) {
            const int l = it / I_L; int r = it % I_L;
            if (r < I_IN) { p0_transpose_item<true>(w_in + (size_t)l * DM * INW, DM, INW, WinT + (size_t)l * INW * DM, scr, r, lane); continue; } r -= I_IN;
            if (r < I_OUT) { p0_transpose_item<false>(w_out + (size_t)l * DM * DM, DM, DM, WoutT + (size_t)l * DM * DM, scr, r, lane); continue; } r -= I_OUT;
            if (r < I_1) { p0_transpose_item<false>(mlp_w1 + (size_t)l * DM * DFF, DM, DFF, W1T + (size_t)l * DFF * DM, scr, r, lane); continue; } r -= I_1;
            p0_transpose_item<false>(mlp_w2 + (size_t)l * DFF * DM, DFF, DM, W2T + (size_t)l * DM * DFF, scr, r, lane);
        }
        __syncthreads();
    }
    SEAM(0);
    if (IN(1)) {
        norm_mod_rows(wv__, x_in, ctx_in, norm1_w, MOD, 0, 1, XN, MTOT, vcu, NGW);
        shift_gemv(wv__, (char*)lds, MOD, 3, W1T, S_UP, DFF, vcu, NGW);
        shift_gemv(wv__, (char*)lds, MOD + (size_t)17 * NMODW, 3, W1T + (size_t)DFF * DM, S_UP + 17 * DFF, DFF, vcu, NGW);
        shift_gemv(wv__, (char*)lds, MOD + (size_t)17 * NMODW, 0, WinT + (size_t)INW * DM, S_IN1, INW, vcu, NGW);
    }
    SEAM(1);
#pragma unroll 1
    for (int l_ = 0; l_ < 2; ++l_) {
        int l = l_; asm volatile("" : "+s"(l));
        const int pb = 2 + 5 * l; const bool last = (l == 1);
        const float* modl = MOD + (size_t)l * 17 * NMODW;
        if (IN(pb)) {
            pg8::Gemm g{XN, WinT + (size_t)l * INW * DM, MTOT, INW, DM}; pg8::StaticOrder S; S.init(MTOT, INW, G, bx);
            if (l == 0) { EpiIn<false> E{P, nullptr, nullptr}; pg8::gemm_phase<EpiIn<false>, pg8::StaticOrder, true, true>(wv__, (LAS unsigned char*)lds, g, S, E); }
            else { EpiIn<true> E{P, RSQ + MTOT, S_IN1}; pg8::gemm_phase<EpiIn<true>, pg8::StaticOrder, true, true>(wv__, (LAS unsigned char*)lds, g, S, E); }
        }
        SEAM(pb);
        if (IN(pb + 1)) {
            const float lam = rfl_f(SCAL[2 * l]), lam_init = rfl_f(SCAL[2 * l + 1]);
            for (int i = 0; i < 2; ++i) {
                const int unit = i * 256 + vcu, bh = unit >> 3, qb = unit & 7, b = bh >> 2, h = bh & 3;
                att::diff_unit(wv__, (char*)lds, P, MIX, SCR, diff_gn + l * 512, lam, lam_init, (long)b * SEQ + qb * 256, (long)b * SEQ, 32, (long)NLAT + b * CTXL, 4, h);
            }
            for (int i = 0; i < 2; ++i) {
                const int unit = i * 256 + vcu, bh = unit >> 3, qb = unit & 7, b = bh >> 2, h = bh & 3;
                const float lf = rfl_f(-__expf(ret_ld[l * 8 + h]) * 1.4426950408889634f), lb = rfl_f(-__expf(ret_ld[l * 8 + 4 + h]) * 1.4426950408889634f);
                att::ret_unit_state(wv__, (char*)lds, P, MIX, ret_gn + l * 256, lf, lb, b, qb, h);
            }
            if (!last) {
                if (vcu < 64) { const int b = vcu >> 2, h = vcu & 3; const long cr = (long)NLAT + b * CTXL;
                    att::diff_unit(wv__, (char*)lds, P, MIX, SCR, diff_gn + l * 512, lam, lam_init, cr, cr, 4, cr, 0, h); }
                else if (vcu < 128) { const int b = (vcu - 64) >> 2, h = vcu & 3; const long cr = (long)NLAT + b * CTXL;
                    const float lf = rfl_f(-__expf(ret_ld[l * 8 + h]) * 1.4426950408889634f), lb = rfl_f(-__expf(ret_ld[l * 8 + 4 + h]) * 1.4426950408889634f);
                    att::ret_unit(wv__, (char*)lds, P, MIX, ret_gn + l * 256, lf, lb, cr, 0, cr, 4, cr, 0, h); }
            }
            const int nconv = last ? 512 : 576, cstep = last ? 256 : 192, cfirst = last ? 255 - vcu : vcu - 64;
            if (cfirst >= 0) for (int cu = cfirst; cu < nconv; cu += cstep) {
                long seqrow; int L, t0;
                if (cu < 512) { seqrow = (long)(cu >> 5) * SEQ; L = SEQ; t0 = (cu & 31) * 64; } else { const int c2 = cu - 512; seqrow = (long)NLAT + (c2 >> 2) * CTXL; L = CTXL; t0 = (c2 & 3) * 64; }
                conv_unit(wv__, (char*)lds, P, MIX, conv_w + l * 31 * 256, conv_b + l * 256, conv_lnw + l * 256, conv_lnb + l * 256, seqrow, L, t0);
            }
        }
        SEAM(pb + 1);
        if (IN(pb + 2)) {
            const int Mo = last ? NLAT : MTOT;
            pg8::Gemm g{MIX, WoutT + (size_t)l * DM * DM, Mo, DM, DM}; pg8::StaticOrder S; S.init(Mo, DM, G, bx);
            EpiRes E{l == 0 ? x_in : out, l == 0 ? ctx_in : CTXRES, out, CTXRES, modl, 2, XN, norm2_w + l * DM, modl, 4, RSQ + (size_t)(2 * l) * MTOT, nullptr, nullptr};
            pg8::gemm_phase<EpiRes, pg8::StaticOrder, true, true>(wv__, (LAS unsigned char*)lds, g, S, E);
        }
        SEAM(pb + 2);
        if (IN(pb + 3)) {
            const int Mo = last ? NLAT : MTOT;
            pg8::Gemm g{XN, W1T + (size_t)l * DFF * DM, Mo, DFF, DM}; pg8::StaticOrder S; S.init(Mo, DFF, G, bx);
            EpiUp E{H, RSQ + (size_t)(2 * l) * MTOT, S_UP + (size_t)l * 17 * DFF};
            pg8::gemm_phase<EpiUp, pg8::StaticOrder, true, true>(wv__, (LAS unsigned char*)lds, g, S, E);
        }
        SEAM(pb + 3);
        {
            float* part0 = (float*)(ws + WS_SCR); float* part1 = (float*)(ws + WS_PART2);
            if (last) {
                pg8::Gemm g{H, W2T + (size_t)l * DM * DFF, NLAT, DM, DFF}; pg8::StaticOrder S; S.init(NLAT, DM, G, bx);
                EpiRes E{out, CTXRES, out, CTXRES, modl, 5, (bf16*)nullptr, norm1_w + DM, MOD + (size_t)17 * NMODW, 1, RSQ + MTOT, part0, part1};
                pg8::gemm_phase<EpiRes, pg8::StaticOrder, true, true>(wv__, (LAS unsigned char*)lds, g, S, E);
            } else {
                pg8::Gemm g{H, W2T + (size_t)l * DM * DFF, MTOT, DM, DFF}; DownL0Order S; S.init(G, bx);
                EpiRes E{out, CTXRES, out, CTXRES, modl, 5, XN, norm1_w + DM, MOD + (size_t)17 * NMODW, 1, RSQ + MTOT, part0, part1};
                pg8::gemm_phase<EpiRes, DownL0Order, true, true>(wv__, (LAS unsigned char*)lds, g, S, E);
                SEAM(pb + 4);
                ctx_combine(wv__, CTXRES, part0, part1, modl + (size_t)16 * NMODW + 5 * DM, norm1_w + DM, MOD + (size_t)17 * NMODW + (size_t)16 * NMODW + 1 * DM, XN + (size_t)NLAT * DM, RSQ + MTOT + NLAT, vcu, NGW);
            }
        }
        SEAM(pb + 4);
    }
    if (IN(12)) final_norm_rows(wv__, out, final_w, vcu, NGW);
#undef IN
#undef SEAM
}

#ifndef MK_SPLIT
#define MK_SPLIT 0
#endif
extern "C" void kernel_launch(void* const* d_in, const int* in_sizes, int n_in, void* d_out, int out_size, void* d_ws, size_t ws_size, hipStream_t stream) {
    static int grid = 0;
    if (grid == 0) {
        if (n_in != 21 || in_sizes[0] != NLAT * DM || out_size != NLAT * DM || ws_size < WS_END) {
            fprintf(stderr, "kernel_launch: unexpected shapes: n_in %d in0 %d out %d ws %zu (need %zu)\n", n_in, n_in > 0 ? in_sizes[0] : -1, out_size, ws_size, (size_t)WS_END); grid = -1; return; }
        int dev = 0, cus = 0, per_cu = 0;
        (void)hipGetDevice(&dev); (void)hipDeviceGetAttribute(&cus, hipDeviceAttributeMultiprocessorCount, dev);
        if (hipFuncSetAttribute((const void*)mega_fwd, hipFuncAttributeMaxDynamicSharedMemorySize, LDS_BYTES) != hipSuccess) { fprintf(stderr, "kernel_launch: hipFuncSetAttribute failed\n"); grid = -1; return; }
        (void)hipOccupancyMaxActiveBlocksPerMultiprocessor(&per_cu, (const void*)mega_fwd, 512, LDS_BYTES);
        (void)hipGetLastError();
        fprintf(stderr, "kernel_launch: cus %d per_cu %d\n", cus, per_cu);
        if (cus < 256 || per_cu < 1) fprintf(stderr, "kernel_launch: needs 256 co-resident workgroups (cus %d, per_cu %d)\n", cus, per_cu);
        grid = 256;
    }
    if (grid < 0) return;
    if (hipMemsetAsync((char*)d_ws + WS_CTL, 0, CTL_ZERO_BYTES, stream) != hipSuccess) { fprintf(stderr, "kernel_launch: memset failed\n"); return; }
    Args a{};
    for (int i = 0; i < 21; ++i) a.in[i] = (const float*)d_in[i];
    a.out = (float*)d_out; a.ws = (unsigned char*)d_ws; a.pad = 0;
#if MK_SPLIT
    for (int p = 0; p < NPHASE; ++p) { a.ph_lo = p; a.ph_hi = p + 1; a.coop = 0; hipLaunchKernelGGL(mega_fwd, dim3(grid), dim3(512), LDS_BYTES, stream, a); }
#else
    a.ph_lo = 0; a.ph_hi = NPHASE; a.coop = 1;
    void* kargs[] = {&a};
    const hipError_t e = hipLaunchCooperativeKernel((const void*)mega_fwd, dim3(grid), dim3(512), kargs, LDS_BYTES, stream);
    if (e != hipSuccess) fprintf(stderr, "kernel_launch: cooperative launch failed: %s (grid %d)\n", hipGetErrorString(e), grid);
#endif
}
```

```cpp
#include <hip/hip_runtime.h>
#include <hip/hip_cooperative_groups.h>
#include <cstdio>
#include <cstdint>
namespace cg = cooperative_groups;
__device__ __forceinline__ int lane_id_volatile() { int l; asm volatile("v_mbcnt_lo_u32_b32 %0, -1, 0\n\tv_mbcnt_hi_u32_b32 %0, -1, %0" : "=v"(l)); return l; }
#define TIDX() (wv__ * 64 + lane_id_volatile())
__device__ __forceinline__ float rfl_f(float x) { return __uint_as_float(__builtin_amdgcn_readfirstlane(__float_as_uint(x))); }
namespace pg8 {
#define PG8_LAS __attribute__((address_space(3)))
typedef unsigned short bf16_t;
typedef short bf16x8 __attribute__((ext_vector_type(8)));
typedef float f32x4 __attribute__((ext_vector_type(4)));
typedef unsigned u32x4 __attribute__((ext_vector_type(4)));
constexpr int BM = 256, BK = 64, HALF = 128, HTB = HALF * BK * 2  , STAGE_BYTES = 8 * HTB, NXCD = 8, WGM = 8;

__host__ __device__ __forceinline__ int lds_byte(int r, int c) { const int st = (r >> 4) * 2 + (c >> 5), rr = r & 15, cc = c & 31, ob = rr * 64 + cc * 2; return st * 1024 + (ob ^ (((ob >> 9) & 1) << 5)); }
__host__ __device__ __forceinline__ void stage_rc(int b, int& R, int& C) { const int st = b / 1024, sb = b % 1024, swz = sb ^ (((sb >> 9) & 1) << 5); R = (st >> 1) * 16 + swz / 64; C = (st & 1) * 32 + (swz % 64) / 2; }
__host__ __device__ __forceinline__ int perm32(int rho) { const int n = rho >> 4, i = rho & 15; return 8 * (i >> 2) + 4 * n + (i & 3); }

struct Unit { int pm, pn, ks; };
struct Gemm { const bf16_t* A; const bf16_t* Bt; int M, N, K; };

struct StaticOrder {
    int nM, nN, nwg, G, c;
    __host__ __device__ void init(int M, int N, int G_, int c_) { nM = M / BM; nN = N / BM; nwg = nM * nN; G = G_; c = c_; }
    __host__ __device__ bool next(int i, Unit& u) const {
        const long L = (long)i * G + c; if (L >= nwg) return false;
        int wgid = (int)L; { const int q = nwg / NXCD, r = nwg % NXCD, xcd = wgid % NXCD, off = wgid / NXCD; wgid = (xcd < r ? xcd * (q + 1) : r * (q + 1) + (xcd - r) * q) + off; }
        const int nig = WGM * nN, gid = wgid / nig, fm = gid * WGM, gsz = (nM - fm) < WGM ? (nM - fm) : WGM;
        u.pm = fm + ((wgid % nig) % gsz); u.pn = (wgid % nig) / gsz; u.ks = -1; return true;
    }
    __device__ __forceinline__ void a_ready(const Unit&) const {}
    __device__ __forceinline__ void done(const Unit&) const {}
};

__device__ __forceinline__ unsigned cvt_pk_bf16(float lo, float hi) { unsigned r; asm volatile("v_cvt_pk_bf16_f32 %0, %1, %2" : "=v"(r) : "v"(lo), "v"(hi)); return r; }
typedef float f32x2 __attribute__((ext_vector_type(2)));
template <class Epi, class Sched, bool ALIGN_EPI = false, bool SP2 = false>
__device__ __forceinline__ void gemm_phase(int wv__, PG8_LAS unsigned char* lds, const Gemm g, const Sched& S, const Epi& E) {
    int tid = TIDX(); asm volatile("" : "+v"(tid));
    const int wid = __builtin_amdgcn_readfirstlane(tid >> 6), lane = tid & 63, wr = wid >> 2, wc = wid & 3, fr = lane & 15, fq = lane >> 4;
    const int K = g.K, nt = K / BK;
    unsigned voffA[2], voffB[2];
#pragma unroll
    for (int i = 0; i < 2; ++i) { int R, C; stage_rc(tid * 16 + i * 8192, R, C); const int Rb = Epi::PERM ? ((R & ~31) + perm32(R & 31)) : R;
        voffA[i] = (unsigned)(R * K + C) * 2u; voffB[i] = (unsigned)(Rb * K + C) * 2u; }
    const size_t kstep = (size_t)(BK * 2);
    const size_t hstep = (size_t)HALF * K * 2;
    const size_t tstep = 2 * hstep;
    const unsigned ldsw = (unsigned)wid * 1024u;
    const int aoff = lds_byte(wr * 64 + fr, fq * 8), boff = lds_byte(wc * 32 + fr, fq * 8);
#define PG8_SA(b, h) (((b) * 2 + (h)) * HTB)
#define PG8_SB(b, h) ((4 + (b) * 2 + (h)) * HTB)
#define PG8_STAGE(bufoff, gbase, voff) do { _Pragma("unroll") for (int _i = 0; _i < 2; ++_i) \
        __builtin_amdgcn_global_load_lds((const unsigned*)((const char*)(gbase) + (voff)[_i]), (PG8_LAS unsigned*)(lds + (bufoff) + ldsw + _i * 8192), 16, 0, 0); } while (0)
#define PG8_LDA(dst, b, h) do { _Pragma("unroll") for (int m = 0; m < 4; ++m) _Pragma("unroll") for (int k = 0; k < 2; ++k) dst[m][k] = *(const PG8_LAS bf16x8*)(lds + PG8_SA(b, h) + aoff + m * 2048 + k * 1024); } while (0)
#define PG8_LDB(dst, b, h) do { _Pragma("unroll") for (int n = 0; n < 2; ++n) _Pragma("unroll") for (int k = 0; k < 2; ++k) dst[n][k] = *(const PG8_LAS bf16x8*)(lds + PG8_SB(b, h) + boff + n * 2048 + k * 1024); } while (0)
#define PG8_MMA(ai, bj, At, Bt) do { __builtin_amdgcn_s_setprio(1); _Pragma("unroll") for (int m = 0; m < 4; ++m) _Pragma("unroll") for (int n = 0; n < 2; ++n) _Pragma("unroll") for (int k = 0; k < 2; ++k) \
        acc[ai][bj][m][n] = __builtin_amdgcn_mfma_f32_16x16x32_bf16(Bt[n][k], At[m][k], acc[ai][bj][m][n], 0, 0, 0); __builtin_amdgcn_s_setprio(0); } while (0)
#define PG8_WAIT_V(n) asm volatile("s_waitcnt vmcnt(" #n ")" ::: "memory")
#define PG8_WAIT_L(n) asm volatile("s_waitcnt lgkmcnt(" #n ")" ::: "memory")
#define PG8_BAR __builtin_amdgcn_s_barrier()
#define PG8_SCHED __builtin_amdgcn_sched_barrier(0)
    Unit cur, nxt; int ui = 0;
    if (!S.next(0, cur)) return;
    f32x4 acc[2][2][4][2];
#pragma unroll
    for (int a = 0; a < 2; ++a)
#pragma unroll
        for (int b = 0; b < 2; ++b)
#pragma unroll
            for (int m = 0; m < 4; ++m)
#pragma unroll
                for (int n = 0; n < 2; ++n) acc[a][b][m][n] = (f32x4){0.f, 0.f, 0.f, 0.f};
    bf16x8 At[4][2], B0[2][2], B1[2][2];
#define PG8_KOFF(u) ((u).ks < 0 ? (size_t)0 : (size_t)(u).ks * (size_t)(K / 4) * 2)
    const char* cA = (const char*)g.A + (size_t)cur.pm * tstep + PG8_KOFF(cur); const char* cB = (const char*)g.Bt + (size_t)cur.pn * tstep + PG8_KOFF(cur);
    S.a_ready(cur);
    if constexpr (SP2) {
        PG8_STAGE(PG8_SB(0, 0), cB, voffB); PG8_STAGE(PG8_SB(0, 1), cB + hstep, voffB); PG8_STAGE(PG8_SA(0, 0), cA, voffA); PG8_STAGE(PG8_SA(0, 1), cA + hstep, voffA);
        if (wr == 1) PG8_BAR;
        PG8_WAIT_V(2); PG8_BAR;
        PG8_STAGE(PG8_SB(1, 0), cB + kstep, voffB); PG8_STAGE(PG8_SA(1, 0), cA + kstep, voffA); PG8_STAGE(PG8_SB(1, 1), cB + hstep + kstep, voffB);
        PG8_WAIT_V(6); PG8_BAR;
    } else {
        PG8_STAGE(PG8_SB(0, 0), cB, voffB); PG8_STAGE(PG8_SA(0, 0), cA, voffA); PG8_STAGE(PG8_SB(0, 1), cB + hstep, voffB); PG8_STAGE(PG8_SA(0, 1), cA + hstep, voffA);
        if (wr == 1) PG8_BAR;
        PG8_WAIT_V(4); PG8_BAR;
        PG8_STAGE(PG8_SB(1, 0), cB + kstep, voffB); PG8_STAGE(PG8_SA(1, 0), cA + kstep, voffA); PG8_STAGE(PG8_SB(1, 1), cB + hstep + kstep, voffB);
        PG8_WAIT_V(6); PG8_BAR;
    }
    for (;;) {
        const bool has_next = S.next(ui + 1, nxt);
        const char* nA = has_next ? (const char*)g.A + (size_t)nxt.pm * tstep + PG8_KOFF(nxt) : cA; const char* nB = has_next ? (const char*)g.Bt + (size_t)nxt.pn * tstep + PG8_KOFF(nxt) : cB;
        const int cnt = cur.ks < 0 ? nt : (nt >> 2);
        for (int t = 0; t < cnt; t += 2) {
            const bool last = (t == cnt - 2);
            const char* a1 = cA + (size_t)(t + 1) * kstep;
            const char* a2 = last ? nA : cA + (size_t)(t + 2) * kstep; const char* b2 = last ? nB : cB + (size_t)(t + 2) * kstep;
            const char* a3 = a2 + kstep; const char* b3 = b2 + kstep;
            if (last && has_next) S.a_ready(nxt);
            if constexpr (SP2) {
            PG8_LDB(B0, 0, 0); PG8_LDB(B1, 0, 1); PG8_SCHED; PG8_LDA(At, 0, 0); PG8_STAGE(PG8_SA(1, 1), a1 + hstep, voffA);
            PG8_WAIT_V(8); PG8_WAIT_L(0); PG8_BAR; PG8_MMA(0, 0, At, B0); PG8_MMA(0, 1, At, B1); PG8_BAR; PG8_SCHED;
            PG8_LDA(At, 0, 1); PG8_STAGE(PG8_SB(0, 0), b2, voffB); PG8_STAGE(PG8_SB(0, 1), b2 + hstep, voffB); PG8_STAGE(PG8_SA(0, 0), a2, voffA);
            PG8_WAIT_V(8); PG8_WAIT_L(0); PG8_BAR; PG8_MMA(1, 0, At, B0); PG8_MMA(1, 1, At, B1); PG8_BAR; PG8_SCHED;
            PG8_LDB(B0, 1, 0); PG8_LDB(B1, 1, 1); PG8_SCHED; PG8_LDA(At, 1, 0); PG8_STAGE(PG8_SA(0, 1), a2 + hstep, voffA);
            PG8_WAIT_V(8); PG8_WAIT_L(0); PG8_BAR; PG8_MMA(0, 0, At, B0); PG8_MMA(0, 1, At, B1); PG8_BAR; PG8_SCHED;
            PG8_LDA(At, 1, 1); PG8_STAGE(PG8_SB(1, 0), b3, voffB); PG8_STAGE(PG8_SB(1, 1), b3 + hstep, voffB); PG8_STAGE(PG8_SA(1, 0), a3, voffA);
            PG8_WAIT_V(8); PG8_WAIT_L(0); PG8_BAR; PG8_MMA(1, 0, At, B0); PG8_MMA(1, 1, At, B1); PG8_BAR; PG8_SCHED;
            } else {
            PG8_LDB(B0, 0, 0); PG8_SCHED; PG8_LDA(At, 0, 0); PG8_STAGE(PG8_SA(1, 1), a1 + hstep, voffA);
            PG8_WAIT_L(8); PG8_BAR; PG8_WAIT_L(0); PG8_MMA(0, 0, At, B0); PG8_BAR; PG8_SCHED;
            PG8_LDB(B1, 0, 1); PG8_STAGE(PG8_SB(0, 0), b2, voffB);
            PG8_BAR; PG8_WAIT_L(0); PG8_MMA(0, 1, At, B1); PG8_BAR;
            PG8_LDA(At, 0, 1); PG8_STAGE(PG8_SA(0, 0), a2, voffA);
            PG8_BAR; PG8_WAIT_L(0); PG8_MMA(1, 0, At, B0); PG8_BAR; PG8_SCHED;
            PG8_STAGE(PG8_SB(0, 1), b2 + hstep, voffB);
            PG8_WAIT_V(6); PG8_BAR; PG8_MMA(1, 1, At, B1); PG8_BAR;
            PG8_LDB(B0, 1, 0); PG8_SCHED; PG8_LDA(At, 1, 0); PG8_STAGE(PG8_SA(0, 1), a2 + hstep, voffA);
            PG8_WAIT_L(8); PG8_BAR; PG8_WAIT_L(0); PG8_MMA(0, 0, At, B0); PG8_BAR; PG8_SCHED;
            PG8_LDB(B1, 1, 1); PG8_STAGE(PG8_SB(1, 0), b3, voffB);
            PG8_BAR; PG8_WAIT_L(0); PG8_MMA(0, 1, At, B1); PG8_BAR;
            PG8_LDA(At, 1, 1); PG8_STAGE(PG8_SA(1, 0), a3, voffA);
            PG8_BAR; PG8_WAIT_L(0); PG8_MMA(1, 0, At, B0); PG8_BAR; PG8_SCHED;
            PG8_STAGE(PG8_SB(1, 1), b3 + hstep, voffB);
            PG8_WAIT_V(6); PG8_BAR; PG8_MMA(1, 1, At, B1); PG8_BAR;
            }
        }
        if constexpr (ALIGN_EPI) { if (wr == 0) PG8_BAR; }
        if constexpr (!Epi::AFTER_DRAIN) { E(acc, cur, wr, wc, fr, fq); S.done(cur); }
        if (!has_next) break;
#pragma unroll
        for (int a = 0; a < 2; ++a)
#pragma unroll
            for (int b = 0; b < 2; ++b)
#pragma unroll
                for (int m = 0; m < 4; ++m)
#pragma unroll
                    for (int n = 0; n < 2; ++n) acc[a][b][m][n] = (f32x4){0.f, 0.f, 0.f, 0.f};
        cur = nxt; cA = nA; cB = nB; ++ui;
        if constexpr (ALIGN_EPI) { if (wr == 1) PG8_BAR; }
    }
    PG8_WAIT_V(0);
    if constexpr (!ALIGN_EPI) { if (wr == 0) PG8_BAR; }
    PG8_BAR;
    if constexpr (Epi::AFTER_DRAIN) { E.fused(acc, cur, wr, wc, fr, fq, lds, wid, lane); S.done(cur); }
#undef PG8_KOFF
#undef PG8_SA
#undef PG8_SB
#undef PG8_STAGE
#undef PG8_LDA
#undef PG8_LDB
#undef PG8_MMA
#undef PG8_WAIT_V
#undef PG8_WAIT_L
#undef PG8_BAR
#undef PG8_SCHED
}
}

constexpr int DM = 1024, NB = 16, SEQ = 2048, CTXL = 256, NLAT = NB * SEQ, NCTX = NB * CTXL, MTOT = NLAT + NCTX;
constexpr int INW = 3072, DFF = 4096, NMODW = 6 * DM;
constexpr float EPSN = 1e-6f;
constexpr size_t MiB = 1u << 20;
constexpr size_t WS_WIN = 0, WS_WOUT = 12 * MiB, WS_W1 = 16 * MiB, WS_W2 = 32 * MiB;
constexpr size_t WS_MOD = 48 * MiB, WS_SCAL = 49 * MiB, WS_CTXRES = 50 * MiB, WS_SCR = 66 * MiB, WS_XN = 98 * MiB, WS_P = 170 * MiB, WS_MIX = 386 * MiB, WS_H = WS_P, WS_CTL = 458 * MiB, WS_RSQ = 459 * MiB  , WS_SB = 460 * MiB  , WS_PART2 = 462 * MiB  , WS_END = 494 * MiB;
constexpr size_t CTL_ZERO_BYTES = 2 * MiB;
constexpr int LDS_BYTES = 148480;

#define LAS __attribute__((address_space(3)))
typedef unsigned short bf16;
typedef unsigned v4u __attribute__((ext_vector_type(4)));
typedef unsigned v2u __attribute__((ext_vector_type(2)));
typedef float f32x4 __attribute__((ext_vector_type(4)));
typedef short bf16x8 __attribute__((ext_vector_type(8)));
typedef short s16x4 __attribute__((ext_vector_type(4)));
typedef float f32x16 __attribute__((ext_vector_type(16)));

__device__ __forceinline__ unsigned f2bf(float f) { unsigned u = __builtin_bit_cast(unsigned, f); return (u + 0x7fffu + ((u >> 16) & 1u)) >> 16; }
__device__ __forceinline__ unsigned pk2(float lo, float hi) { return f2bf(lo) | (f2bf(hi) << 16); }
__device__ __forceinline__ float bf2f(unsigned short h) { return __builtin_bit_cast(float, (unsigned)h << 16); }
__device__ __forceinline__ float wave_sum(float v) {
#pragma unroll
    for (int o = 1; o < 64; o <<= 1) v += __shfl_xor(v, o);
    return v;
}
__device__ __forceinline__ float half_sum32(float v) {
#pragma unroll
    for (int o = 1; o < 32; o <<= 1) v += __shfl_xor(v, o);
    return v;
}
__device__ __forceinline__ float fast_sigmoid(float v) { return __builtin_amdgcn_rcpf(1.f + __builtin_amdgcn_exp2f(-1.4426950408889634f * v)); }

__host__ __device__ __forceinline__ int win_src_col(int p) {
    const int pn = p >> 8, q = p & 255, bj = q >> 7, wc = (q >> 5) & 3, j = q & 31;
    if (pn < 4) return pn * 256 + 64 * wc + 32 * bj + j;
    if (pn < 8) return pn * 256 + 64 * wc + 16 * bj + j + ((j >= 16) ? 16 : 0);
    if (pn < 10) return p;
    return 2560 + 256 * bj + 128 * (pn - 10) + 32 * wc + j;
}
constexpr float QSCALE = 0.125f * 1.4426950408889634f;
constexpr float LOG2_10000 = 13.287712379549449f;
constexpr float INV_2PI = 0.15915494309189535f;

template <bool FUSED>
struct EpiIn {
    static constexpr bool PERM = true, AFTER_DRAIN = false;
    bf16* P; const float* rowsq; const float* S;
    __device__ __forceinline__ void operator()(const pg8::f32x4 (&acc0)[2][2][4][2], const pg8::Unit& u, int wr, int wc, int fr, int fq) const {
        const int pn = u.pn; const int row0 = u.pm * 256 + wr * 64 + fr; const bool latent = u.pm < (NLAT / 256);
        pg8::f32x4 acc[2][2][4][2];
        if (FUSED) {
            const float* sp = S + (size_t)(latent ? (u.pm >> 3) : 16) * INW + pn * 256 + wc * 32 + 8 * fq;
            pg8::f32x4 sv[2][2];
#pragma unroll
            for (int bj = 0; bj < 2; ++bj)
#pragma unroll
                for (int n = 0; n < 2; ++n) sv[bj][n] = *(const pg8::f32x4*)(sp + bj * 128 + 4 * n);
#pragma unroll
            for (int ai = 0; ai < 2; ++ai)
#pragma unroll
                for (int m = 0; m < 4; ++m) { const float rs = __builtin_amdgcn_rsqf(rowsq[row0 + ai * 128 + m * 16] * (1.f / DM) + EPSN);
#pragma unroll
                    for (int bj = 0; bj < 2; ++bj)
#pragma unroll
                        for (int n = 0; n < 2; ++n) acc[ai][bj][m][n] = acc0[ai][bj][m][n] * rs + sv[bj][n]; }
        } else {
#pragma unroll
            for (int ai = 0; ai < 2; ++ai)
#pragma unroll
                for (int bj = 0; bj < 2; ++bj)
#pragma unroll
                    for (int m = 0; m < 4; ++m)
#pragma unroll
                        for (int n = 0; n < 2; ++n) acc[ai][bj][m][n] = acc0[ai][bj][m][n];
        }
        if (pn < 8) {
            const bool ret = pn < 4;
            const bool rope = latent && (pn < 2 || pn >= 4);
            const float exstep = ret ? (1.f / 32.f) : (1.f / 16.f); const float ex0 = ret ? (float)(8 * fq) * (1.f / 32.f) : (float)((8 * fq) & 15) * (1.f / 16.f);
            const float sc = (pn == 1) ? 0.125f : ((pn == 4 || pn == 5) ? QSCALE : 1.f);
            const int cbase = ret ? (pn * 256 + 64 * wc + 8 * fq) : (pn * 256 + 64 * wc + 8 * fq);
#pragma unroll
            for (int ai = 0; ai < 2; ++ai)
#pragma unroll
                for (int m = 0; m < 4; ++m) {
                    const int row = row0 + ai * 128 + m * 16; const int t = row & (SEQ - 1);
                    const float pos = ret ? (float)t : ((fq < 2) ? (float)(t >> 6) : (float)(t & 63));
                    float o1[8], o2[8];
#pragma unroll
                    for (int n = 0; n < 2; ++n)
#pragma unroll
                        for (int e = 0; e < 4; ++e) {
                            const float x1 = acc[ai][0][m][n][e], x2 = acc[ai][1][m][n][e];
                            float y1 = x1, y2 = x2;
                            if (rope) { float rv = pos * (__builtin_amdgcn_exp2f(-(ex0 + (float)(n * 4 + e) * exstep + 0.f * pos) * LOG2_10000) * INV_2PI); rv = rv - __builtin_floorf(rv); const float sn = __builtin_amdgcn_sinf(rv), cs = __builtin_amdgcn_cosf(rv);
                                y1 = x1 * cs - x2 * sn; y2 = x2 * cs + x1 * sn; }
                            if (pn == 3) { y1 = y1 * fast_sigmoid(y1); y2 = y2 * fast_sigmoid(y2); }
                            o1[n * 4 + e] = y1 * sc; o2[n * 4 + e] = y2 * sc;
                        }
                    bf16* rp = P + (size_t)row * INW + cbase;
                    v4u w1, w2; w1.x = pk2(o1[0], o1[1]); w1.y = pk2(o1[2], o1[3]); w1.z = pk2(o1[4], o1[5]); w1.w = pk2(o1[6], o1[7]);
                    w2.x = pk2(o2[0], o2[1]); w2.y = pk2(o2[2], o2[3]); w2.z = pk2(o2[4], o2[5]); w2.w = pk2(o2[6], o2[7]);
                    *(v4u*)rp = w1; *(v4u*)(rp + 32) = w2;
                    __builtin_amdgcn_sched_barrier(0);
                }
        } else if (pn < 10) {
            const int cbase = pn * 256 + 32 * wc + 8 * fq;
#pragma unroll
            for (int ai = 0; ai < 2; ++ai)
#pragma unroll
                for (int m = 0; m < 4; ++m) {
                    bf16* rp = P + (size_t)(row0 + ai * 128 + m * 16) * INW + cbase;
#pragma unroll
                    for (int bj = 0; bj < 2; ++bj) { const pg8::f32x4 a = acc[ai][bj][m][0], b = acc[ai][bj][m][1];
                        v4u w; w.x = pk2(a[0], a[1]); w.y = pk2(a[2], a[3]); w.z = pk2(b[0], b[1]); w.w = pk2(b[2], b[3]); *(v4u*)(rp + bj * 128) = w; }
                }
        } else {
            const int cbase = 2560 + 128 * (pn - 10) + 32 * wc + 8 * fq;
#pragma unroll
            for (int ai = 0; ai < 2; ++ai)
#pragma unroll
                for (int m = 0; m < 4; ++m) {
                    bf16* rp = P + (size_t)(row0 + ai * 128 + m * 16) * INW + cbase;
                    float o[8];
#pragma unroll
                    for (int n = 0; n < 2; ++n)
#pragma unroll
                        for (int e = 0; e < 4; ++e) o[n * 4 + e] = acc[ai][0][m][n][e] * fast_sigmoid(acc[ai][1][m][n][e]);
                    v4u w; w.x = pk2(o[0], o[1]); w.y = pk2(o[2], o[3]); w.z = pk2(o[4], o[5]); w.w = pk2(o[6], o[7]); *(v4u*)rp = w;
                }
        }
    }
};
struct DownL0Order {
    pg8::StaticOrder lat; int c;
    __device__ void init(int G_, int c_) { lat.init(NLAT, DM, G_, c_); c = c_; }
    __device__ bool next(int i, pg8::Unit& u) const {
        if (i < 2) return lat.next(i, u);
        if (i == 2) { const int tile = c >> 2; u.pm = NLAT / 256 + (tile >> 2); u.pn = tile & 3; u.ks = c & 3; return true; }
        return false;
    }
    __device__ __forceinline__ void a_ready(const pg8::Unit&) const {}
    __device__ __forceinline__ void done(const pg8::Unit&) const {}
};
struct EpiRes {
    static constexpr bool PERM = true, AFTER_DRAIN = false;
    const float* baseL; const float* baseC; float* outL; float* outC; const float* modl; int gidx;
    bf16* XN; const float* nw; const float* modN; int sci; float* rowsq; float* part0; float* part1;
    __device__ __forceinline__ void operator()(const pg8::f32x4 (&acc)[2][2][4][2], const pg8::Unit& u, int wr, int wc, int fr, int fq) const {
        const bool latent = u.pm < (NLAT / 256);
        if (u.ks >= 0) {
            float* pp = (u.ks < 2 ? part0 : part1) + (size_t)(u.ks & 1) * NCTX * DM + (size_t)((u.pm - NLAT / 256) * 256 + wr * 64 + fr) * DM + u.pn * 256 + wc * 32 + 8 * fq;
#pragma unroll
            for (int ai = 0; ai < 2; ++ai)
#pragma unroll
                for (int m = 0; m < 4; ++m)
#pragma unroll
                    for (int bj = 0; bj < 2; ++bj)
#pragma unroll
                        for (int n = 0; n < 2; ++n) *(pg8::f32x4*)(pp + (size_t)(ai * 128 + m * 16) * DM + bj * 128 + 4 * n) = acc[ai][bj][m][n];
            return;
        }
        const int rowt = (latent ? u.pm * 256 : (u.pm - NLAT / 256) * 256) + wr * 64 + fr;
        const int rowg = u.pm * 256 + wr * 64 + fr;
        const float* base = latent ? baseL : baseC; float* out = latent ? outL : outC;
        const int b = latent ? (u.pm >> 3) : 16;
        const int col0 = u.pn * 256 + wc * 32 + 8 * fq;
        const float* gp = modl + (size_t)b * NMODW + gidx * DM + col0;
        pg8::f32x4 gv[2][2], nv[2][2];
#pragma unroll
        for (int bj = 0; bj < 2; ++bj)
#pragma unroll
            for (int n = 0; n < 2; ++n) { gv[bj][n] = *(const pg8::f32x4*)(gp + bj * 128 + 4 * n);
                if (XN) nv[bj][n] = *(const pg8::f32x4*)(nw + col0 + bj * 128 + 4 * n) * (*(const pg8::f32x4*)(modN + (size_t)b * NMODW + sci * DM + col0 + bj * 128 + 4 * n) + 1.f); }
#pragma unroll
        for (int ai = 0; ai < 2; ++ai)
#pragma unroll
            for (int m = 0; m < 4; ++m) { const size_t off = (size_t)(rowt + ai * 128 + m * 16) * DM + col0; float ss = 0.f;
#pragma unroll
                for (int bj = 0; bj < 2; ++bj) { pg8::f32x4 x[2];
#pragma unroll
                    for (int n = 0; n < 2; ++n) { const pg8::f32x4 bs = *(const pg8::f32x4*)(base + off + bj * 128 + 4 * n);
                        x[n] = bs + gv[bj][n] * acc[ai][bj][m][n];
                        *(pg8::f32x4*)(out + off + bj * 128 + 4 * n) = x[n]; }
                    if (XN) { ss += (x[0][0] * x[0][0] + x[0][1] * x[0][1]) + (x[0][2] * x[0][2] + x[0][3] * x[0][3]) + (x[1][0] * x[1][0] + x[1][1] * x[1][1]) + (x[1][2] * x[1][2] + x[1][3] * x[1][3]);
                        const pg8::f32x4 y0 = x[0] * nv[bj][0], y1 = x[1] * nv[bj][1];
                        v4u w; w.x = pk2(y0[0], y0[1]); w.y = pk2(y0[2], y0[3]); w.z = pk2(y1[0], y1[1]); w.w = pk2(y1[2], y1[3]);
                        *(v4u*)(XN + (size_t)(rowg + ai * 128 + m * 16) * DM + col0 + bj * 128) = w; } }
                if (XN) { ss += __shfl_xor(ss, 16); ss += __shfl_xor(ss, 32);
                    if (fq == 0) atomicAdd(rowsq + rowg + ai * 128 + m * 16, ss); } }
    }
};
struct EpiUp {
    static constexpr bool PERM = true, AFTER_DRAIN = false;
    bf16* H; const float* rowsq; const float* S;
    __device__ __forceinline__ void operator()(const pg8::f32x4 (&acc)[2][2][4][2], const pg8::Unit& u, int wr, int wc, int fr, int fq) const {
        const int row0 = u.pm * 256 + wr * 64 + fr, col0 = u.pn * 256 + wc * 32 + 8 * fq;
        const float* sp = S + (size_t)((u.pm < NLAT / 256) ? (u.pm >> 3) : 16) * DFF + col0;
        pg8::f32x4 sv[2][2];
#pragma unroll
        for (int bj = 0; bj < 2; ++bj)
#pragma unroll
            for (int n = 0; n < 2; ++n) sv[bj][n] = *(const pg8::f32x4*)(sp + bj * 128 + 4 * n);
#pragma unroll
        for (int ai = 0; ai < 2; ++ai)
#pragma unroll
            for (int m = 0; m < 4; ++m) { bf16* rp = H + (size_t)(row0 + ai * 128 + m * 16) * DFF + col0;
                const float rs = __builtin_amdgcn_rsqf(rowsq[row0 + ai * 128 + m * 16] * (1.f / DM) + EPSN);
#pragma unroll
                for (int bj = 0; bj < 2; ++bj) { pg8::f32x4 a = acc[ai][bj][m][0] * rs + sv[bj][0], b = acc[ai][bj][m][1] * rs + sv[bj][1];
#pragma unroll
                    for (int e = 0; e < 4; ++e) { const float x = fmaxf(a[e], 0.f), y = fmaxf(b[e], 0.f); a[e] = x * x; b[e] = y * y; }
                    v4u w; w.x = pk2(a[0], a[1]); w.y = pk2(a[2], a[3]); w.z = pk2(b[0], b[1]); w.w = pk2(b[2], b[3]); *(v4u*)(rp + bj * 128) = w; } }
    }
};
#define XB_TMO      128
#define XB_XCNT(j)  (256  + 64 * (j))
#define XB_XSUB(j)  (1280 + 64 * (j))
#define XB_XGEN(j)  (2304 + 64 * (j))
#define XB_TOP      3328
#define XB_TOPGEN   3392
#define XCD_BAR_WORDS 3456
#define XB_SPIN_CAP (1u << 18)

__device__ __forceinline__ unsigned xb_ld(unsigned* p)              { return __hip_atomic_load(p, __ATOMIC_RELAXED, __HIP_MEMORY_SCOPE_AGENT); }
__device__ __forceinline__ unsigned xb_add(unsigned* p, unsigned v) { return __hip_atomic_fetch_add(p, v, __ATOMIC_RELAXED, __HIP_MEMORY_SCOPE_AGENT); }
__device__ __forceinline__ unsigned xb_xcc_id() { return (unsigned)__builtin_amdgcn_s_getreg((3 << 11) | 20) & 0xFu; }
#define XB_SPIN(cond, bar) do { unsigned _sp = 0; while (cond) { __builtin_amdgcn_s_sleep(1); \
    if ((++_sp & 255u) == 0u) { if (xb_ld(&(bar)[XB_TMO])) break; if (_sp > XB_SPIN_CAP) { atomicAdd(&(bar)[XB_TMO], 1u); break; } } } } while (0)

struct XcdBarrier {
    unsigned* bar; unsigned x;
    volatile LAS unsigned* st;
};

__device__ __forceinline__ XcdBarrier xcd_barrier_post(int wv__, unsigned* bar, volatile LAS unsigned* st) {
    XcdBarrier b; b.bar = bar; b.x = xb_xcc_id(); b.st = st;
    if (TIDX() == 0) (void)xb_add(&bar[XB_XCNT(b.x)], 1u);
    return b;
}
__device__ __forceinline__ void xcd_barrier_complete(unsigned* bar, unsigned x, unsigned& nloc, unsigned& nx) {
    const unsigned G = gridDim.x * gridDim.y * gridDim.z;
    unsigned sum, cnt, mine, sp = 0u;
    for (;;) {
        sum = 0u; cnt = 0u; mine = 0u;
#pragma unroll
        for (unsigned j = 0; j < 16; ++j) { const unsigned c = xb_ld(&bar[XB_XCNT(j)]); sum += c; cnt += (c > 0u) ? 1u : 0u; mine = (j == x) ? c : mine; }
        if (sum == G) break;
        __builtin_amdgcn_s_sleep(1);
        if ((++sp & 255u) == 0u) { if (xb_ld(&bar[XB_TMO])) break; if (sp > XB_SPIN_CAP) { atomicAdd(&bar[XB_TMO], 1u); break; } }
    }
    nloc = mine > 0u ? mine : 1u; nx = cnt > 0u ? cnt : 1u;
}

__device__ __forceinline__ void xcd_barrier(int wv__, const XcdBarrier& b) {
    asm volatile("s_waitcnt vmcnt(0)" ::: "memory");
    __syncthreads();
    if (TIDX() == 0) {
        unsigned* bar = b.bar;
        __builtin_amdgcn_s_waitcnt(0);
        unsigned nloc = b.st[0], nx = b.st[1];
        if (nloc == 0u) { xcd_barrier_complete(bar, b.x, nloc, nx); b.st[0] = nloc; b.st[1] = nx; }
        const unsigned old = xb_add(&bar[XB_XSUB(b.x)], 1u);
        const unsigned gen = old / nloc;
        if (old + 1u == (gen + 1u) * nloc) {
            __builtin_amdgcn_fence(__ATOMIC_RELEASE, "agent");
            asm volatile("s_waitcnt vmcnt(0)" ::: "memory");
            const unsigned og = xb_add(&bar[XB_TOP], 1u);
            const unsigned tg = og / nx;
            if (og + 1u == (tg + 1u) * nx) xb_add(&bar[XB_TOPGEN], 1u);
            else XB_SPIN(xb_ld(&bar[XB_TOPGEN]) == tg, bar);
            __builtin_amdgcn_fence(__ATOMIC_ACQUIRE, "agent");
            xb_add(&bar[XB_XGEN(b.x)], 1u);
            asm volatile("s_waitcnt vmcnt(0)" ::: "memory");
        } else {
            XB_SPIN(xb_ld(&bar[XB_XGEN(b.x)]) == gen, bar);
            __builtin_amdgcn_fence(__ATOMIC_ACQUIRE, "agent");
            asm volatile("s_waitcnt vmcnt(0)" ::: "memory");
        }
    }
    __syncthreads();
}

namespace att {
#define SBAR() __builtin_amdgcn_sched_barrier(0)
#define KSWZ64(row, colB) ((row) * 128 + ((colB) ^ ((((row) >> 1) & 7) << 4)))
constexpr int LV = 0, LK = 32768, LWS = 49152;
__device__ __forceinline__ int crow(int r, int hi) { return (r & 3) + 8 * (r >> 2) + 4 * hi; }
__device__ __forceinline__ unsigned cvtpk(float lo, float hi) { unsigned r; asm volatile("v_cvt_pk_bf16_f32 %0, %1, %2" : "=v"(r) : "v"(lo), "v"(hi)); return r; }
template <int NCB> __device__ __forceinline__ int v_st(int k, int c) { const int kk = (k & ~0xC) | ((k & 4) << 1) | ((k & 8) >> 1); return ((kk >> 3) * NCB + (c >> 5)) * 512 + ((kk & 7) * 32 + (c & 31)) * 2; }
__device__ __forceinline__ int v_rd_base(int lane) { return ((lane & 3) << 3) | (((lane >> 2) & 3) << 6) | (((lane >> 4) & 1) << 5) | (((lane >> 5) & 1) << 8); }
template <int OFF> __device__ __forceinline__ s16x4 tr_read(int vb) { s16x4 r; asm volatile("ds_read_b64_tr_b16 %0, %1 offset:%2" : "=&v"(r) : "v"(vb), "i"(OFF) : "memory"); return r; }
template <int NCB, int D0> __device__ __forceinline__ void pv_one(f32x16& od, int vb, bf16x8 pa0, bf16x8 pa1, bf16x8 pa2, bf16x8 pa3) {
#define VOFF(ks, half) (D0 * 512 + (ks) * (NCB * 1024) + (half) * (NCB * 512))
    const s16x4 l0 = tr_read<VOFF(0, 0)>(vb), h0 = tr_read<VOFF(0, 1)>(vb), l1 = tr_read<VOFF(1, 0)>(vb), h1 = tr_read<VOFF(1, 1)>(vb);
    const s16x4 l2 = tr_read<VOFF(2, 0)>(vb), h2 = tr_read<VOFF(2, 1)>(vb), l3 = tr_read<VOFF(3, 0)>(vb), h3 = tr_read<VOFF(3, 1)>(vb);
#undef VOFF
    asm volatile("s_waitcnt lgkmcnt(0)" ::: "memory"); SBAR();
#define PK(L, H) (bf16x8){L[0], L[1], L[2], L[3], H[0], H[1], H[2], H[3]}
    od = __builtin_amdgcn_mfma_f32_32x32x16_bf16(pa0, PK(l0, h0), od, 0, 0, 0);
    od = __builtin_amdgcn_mfma_f32_32x32x16_bf16(pa1, PK(l1, h1), od, 0, 0, 0);
    od = __builtin_amdgcn_mfma_f32_32x32x16_bf16(pa2, PK(l2, h2), od, 0, 0, 0);
    od = __builtin_amdgcn_mfma_f32_32x32x16_bf16(pa3, PK(l3, h3), od, 0, 0, 0);
#undef PK
}
#define PK4(P, BASE, OUT) do { unsigned a0 = cvtpk(P[BASE + 0], P[BASE + 1]), a1 = cvtpk(P[BASE + 2], P[BASE + 3]);   \
    unsigned b0 = cvtpk(P[BASE + 4], P[BASE + 5]), b1 = cvtpk(P[BASE + 6], P[BASE + 7]);                              \
    auto r0 = __builtin_amdgcn_permlane32_swap(a0, b0, false, false); auto r1 = __builtin_amdgcn_permlane32_swap(a1, b1, false, false); \
    v4u w = {r0[0], r1[0], r0[1], r1[1]}; OUT = *reinterpret_cast<bf16x8*>(&w); } while (0)

struct CoreArgs {
    const bf16* P;
    long qrow;
    int qcol, kcol, vcol;
    long kr_a; int nt_a;
    long kr_b; int nt_b;
    int ipos0;
    float lf, lb;
};
template <int DV, int MODE>
__device__ __forceinline__ void attn_core(int wv__, char* lds, const CoreArgs& A, f32x16 (&o)[DV / 32], float& l_reg) {
    constexpr int NCB = DV / 32, VBYTES = 64 * DV * 2, KBYTES = 8192; constexpr float THR = 8.f;
    int tid = TIDX(); asm volatile("" : "+v"(tid));
    const int wid = tid >> 6, lane = tid & 63, r32 = lane & 31, hi = lane >> 5;
    float* al_l = (float*)(lds + LWS) + wid * 64;
    const int NT = A.nt_a + A.nt_b;
    bf16x8 qr[4];
    { const bf16* Qw = A.P + (size_t)(A.qrow + wid * 32 + r32) * INW + A.qcol + hi * 8;
#pragma unroll
      for (int d0 = 0; d0 < 4; ++d0) qr[d0] = *reinterpret_cast<const bf16x8*>(Qw + d0 * 16); }
#pragma unroll
    for (int d = 0; d < NCB; ++d) o[d] = f32x16{};
    float m_reg = -1e30f; l_reg = 0.f;
    const int kr = tid >> 3, kc = (tid & 7) * 8;
    const int kdst = KSWZ64(kr, kc * 2);
    int vr0, vc0, vdst0, vdst1;
    if (DV == 128) { vr0 = tid >> 4; vc0 = (tid & 15) * 8; vdst0 = v_st<NCB>(vr0, vc0); vdst1 = v_st<NCB>(vr0 + 32, vc0); }
    else { vr0 = tid >> 3; vc0 = (tid & 7) * 8; vdst0 = v_st<NCB>(vr0, vc0); vdst1 = 0; }
    const int vb0 = (int)(uintptr_t)(lds + LV) + v_rd_base(lane);
    bf16x8 sk, sv0, sv1;
#define KROW(t) ((t) < A.nt_a ? A.kr_a + 64 * (t) : A.kr_b + 64 * ((t) - A.nt_a))
#define SLOAD(t) do { const long kb_ = KROW(t); sk = *reinterpret_cast<const bf16x8*>(A.P + (size_t)(kb_ + kr) * INW + A.kcol + kc); \
        sv0 = *reinterpret_cast<const bf16x8*>(A.P + (size_t)(kb_ + vr0) * INW + A.vcol + vc0); \
        if (DV == 128) sv1 = *reinterpret_cast<const bf16x8*>(A.P + (size_t)(kb_ + vr0 + 32) * INW + A.vcol + vc0); } while (0)
#define SWRITE(b) do { *(bf16x8*)(lds + LK + (b) * KBYTES + kdst) = sk; *(bf16x8*)(lds + LV + (b) * VBYTES + vdst0) = sv0; \
        if (DV == 128) *(bf16x8*)(lds + LV + (b) * VBYTES + vdst1) = sv1; } while (0)
    SLOAD(0); SWRITE(0); __syncthreads();
    const int iq0w = A.ipos0 + wid * 32, iq = iq0w + r32;
    float KF[16], KB[16];
    if (MODE == 1) {
#pragma unroll
        for (int r = 0; r < 16; ++r) { const float jj = (float)((r & 3) + 8 * (r >> 2)); KF[r] = __builtin_amdgcn_exp2f(-A.lf * jj); KB[r] = __builtin_amdgcn_exp2f(A.lb * jj); }
    }
#pragma unroll 1
    for (int t = 0; t < NT; ++t) {
        const int buf = t & 1;
        if (t + 1 < NT) SLOAD(t + 1);
        f32x16 p0 = f32x16{}, p1 = f32x16{};
        { const char* Ks = lds + LK + buf * KBYTES;
#pragma unroll
          for (int d0 = 0; d0 < 4; ++d0) { const int cb = (d0 * 16 + hi * 8) * 2;
            const bf16x8 b0 = *reinterpret_cast<const bf16x8*>(Ks + KSWZ64(r32, cb));
            const bf16x8 b1 = *reinterpret_cast<const bf16x8*>(Ks + KSWZ64(32 + r32, cb));
            p0 = __builtin_amdgcn_mfma_f32_32x32x16_bf16(b0, qr[d0], p0, 0, 0, 0);
            p1 = __builtin_amdgcn_mfma_f32_32x32x16_bf16(b1, qr[d0], p1, 0, 0, 0); } }
        if (MODE == 0) {
            float pmax = p0[0];
#pragma unroll
            for (int r = 1; r < 16; ++r) pmax = fmaxf(pmax, p0[r]);
#pragma unroll
            for (int r = 0; r < 16; ++r) pmax = fmaxf(pmax, p1[r]);
            { auto rr = __builtin_amdgcn_permlane32_swap(__float_as_uint(pmax), __float_as_uint(pmax), false, false);
              pmax = fmaxf(__uint_as_float(rr[0]), __uint_as_float(rr[1])); }
            float mn, alpha;
            if (__builtin_expect(__all(pmax - m_reg <= THR), 1)) { mn = m_reg; alpha = 1.f; }
            else { mn = fmaxf(m_reg, pmax); alpha = __builtin_amdgcn_exp2f(m_reg - mn); m_reg = mn; }
#pragma unroll
            for (int r = 0; r < 16; ++r) { p0[r] = __builtin_amdgcn_exp2f(p0[r] - mn); p1[r] = __builtin_amdgcn_exp2f(p1[r] - mn); }
            float ps = 0.f;
#pragma unroll
            for (int r = 0; r < 16; ++r) ps += p0[r] + p1[r];
            { auto rr = __builtin_amdgcn_permlane32_swap(__float_as_uint(ps), __float_as_uint(ps), false, false);
              ps = __uint_as_float(rr[0]) + __uint_as_float(rr[1]); }
            l_reg = l_reg * alpha + ps;
            if (__any(alpha < 1.f)) { if (hi == 0) al_l[r32] = alpha; asm volatile("s_waitcnt lgkmcnt(0)" ::: "memory");
#pragma unroll
                for (int d = 0; d < NCB; ++d)
#pragma unroll
                    for (int r = 0; r < 16; ++r) o[d][r] *= al_l[crow(r, hi)];
            }
        } else {
            if (t < A.nt_a) {
                const int rel = iq0w - 64 * t;
                if (rel > 63) {
                    const float e = A.lf * (float)(iq - 64 * t - 4 * hi);
                    const float R0 = __builtin_amdgcn_exp2f(e), R1 = __builtin_amdgcn_exp2f(e - 32.f * A.lf);
#pragma unroll
                    for (int r = 0; r < 16; ++r) { p0[r] *= R0 * KF[r]; p1[r] *= R1 * KF[r]; }
                } else if (rel < -31) {
                    const float e = A.lb * (float)(64 * t + 4 * hi - iq);
                    const float R0 = __builtin_amdgcn_exp2f(e), R1 = __builtin_amdgcn_exp2f(e + 32.f * A.lb);
#pragma unroll
                    for (int r = 0; r < 16; ++r) { p0[r] *= R0 * KB[r]; p1[r] *= R1 * KB[r]; }
                } else {
                    const int dj0 = iq - 64 * t - 4 * hi;
#pragma unroll
                    for (int r = 0; r < 16; ++r) {
                        const int d0_ = dj0 - ((r & 3) + 8 * (r >> 2)), d1_ = d0_ - 32;
                        const float f0 = (float)d0_, f1 = (float)d1_;
                        float e0 = __builtin_amdgcn_exp2f(d0_ >= 0 ? A.lf * f0 : -A.lb * f0); if (d0_ == 0) e0 += 1.f;
                        float e1 = __builtin_amdgcn_exp2f(d1_ >= 0 ? A.lf * f1 : -A.lb * f1); if (d1_ == 0) e1 += 1.f;
                        p0[r] *= e0; p1[r] *= e1;
                    }
                }
            } else {
                const int m0 = 64 * (t - A.nt_a) + 4 * hi;
                const float ef = A.lf * (float)(iq + CTXL - m0), eb = A.lb * (float)(SEQ - iq + m0);
                const float F0 = __builtin_amdgcn_exp2f(ef), F1 = __builtin_amdgcn_exp2f(ef - 32.f * A.lf), B0 = __builtin_amdgcn_exp2f(eb), B1 = __builtin_amdgcn_exp2f(eb + 32.f * A.lb);
#pragma unroll
                for (int r = 0; r < 16; ++r) { p0[r] *= F0 * KF[r] + B0 * KB[r]; p1[r] *= F1 * KF[r] + B1 * KB[r]; }
            }
        }
        bf16x8 pa0, pa1, pa2, pa3;
        PK4(p0, 0, pa0); PK4(p0, 8, pa1); PK4(p1, 0, pa2); PK4(p1, 8, pa3);
        SBAR();
        { const int vb = vb0 + buf * VBYTES;
          pv_one<NCB, 0>(o[0], vb, pa0, pa1, pa2, pa3); pv_one<NCB, 1>(o[1], vb, pa0, pa1, pa2, pa3);
          if constexpr (NCB == 4) { pv_one<NCB, 2>(o[2], vb, pa0, pa1, pa2, pa3); pv_one<NCB, 3>(o[3], vb, pa0, pa1, pa2, pa3); } }
        if (t + 1 < NT) SWRITE(buf ^ 1);
        __syncthreads();
    }
#undef KROW
#undef SLOAD
#undef SWRITE
}

template <int DV>
__device__ __forceinline__ bool attn_core_fast(int wv__, char* lds, const CoreArgs& A, f32x16 (&o)[DV / 32], float& l_reg) {
    constexpr int NCB = DV / 32, VBYTES = 64 * DV * 2, KBYTES = 8192; constexpr float THR = 8.f;
    static_assert(DV == 128, "softmax core is written for 128 value columns");
    int tid = TIDX(); asm volatile("" : "+v"(tid));
    const int wid = tid >> 6, lane = tid & 63, r32 = lane & 31, hi = lane >> 5;
    float* al_l = (float*)(lds + LWS) + wid * 64;
    const int NT = A.nt_a + A.nt_b;
    bf16x8 qr[4];
    { const bf16* Qw = A.P + (size_t)(A.qrow + wid * 32 + r32) * INW + A.qcol + hi * 8;
#pragma unroll
      for (int d0 = 0; d0 < 4; ++d0) qr[d0] = *reinterpret_cast<const bf16x8*>(Qw + d0 * 16); }
#pragma unroll
    for (int d = 0; d < NCB; ++d) o[d] = f32x16{};
    float m_reg = -1e30f; l_reg = 0.f;
    const int kr = tid >> 3, kc = (tid & 7) * 8;
    const int kdst = KSWZ64(kr, kc * 2);
    const int vr0 = tid >> 4, vc0 = (tid & 15) * 8, vdst0 = v_st<NCB>(vr0, vc0), vdst1 = v_st<NCB>(vr0 + 32, vc0);
    const int vb0 = (int)(uintptr_t)(lds + LV) + v_rd_base(lane);
    bf16x8 sk, sv0, sv1;
#define KROW(t) ((t) < A.nt_a ? A.kr_a + 64 * (t) : A.kr_b + 64 * ((t) - A.nt_a))
#define SLOAD(t) do { const long kb_ = KROW(t); sk = *reinterpret_cast<const bf16x8*>(A.P + (size_t)(kb_ + kr) * INW + A.kcol + kc); \
        sv0 = *reinterpret_cast<const bf16x8*>(A.P + (size_t)(kb_ + vr0) * INW + A.vcol + vc0); \
        sv1 = *reinterpret_cast<const bf16x8*>(A.P + (size_t)(kb_ + vr0 + 32) * INW + A.vcol + vc0); } while (0)
#define SWRITE(b) do { *(bf16x8*)(lds + LK + (b) * KBYTES + kdst) = sk; *(bf16x8*)(lds + LV + (b) * VBYTES + vdst0) = sv0; \
        *(bf16x8*)(lds + LV + (b) * VBYTES + vdst1) = sv1; } while (0)
#define QKT(P0, P1, b) do { const char* Ks = lds + LK + (b) * KBYTES; P0 = f32x16{}; P1 = f32x16{}; \
        _Pragma("unroll") for (int d0 = 0; d0 < 4; ++d0) { const int cb = (d0 * 16 + hi * 8) * 2; \
            const bf16x8 b0 = *reinterpret_cast<const bf16x8*>(Ks + KSWZ64(r32, cb)); const bf16x8 b1 = *reinterpret_cast<const bf16x8*>(Ks + KSWZ64(32 + r32, cb)); \
            P0 = __builtin_amdgcn_mfma_f32_32x32x16_bf16(b0, qr[d0], P0, 0, 0, 0); P1 = __builtin_amdgcn_mfma_f32_32x32x16_bf16(b1, qr[d0], P1, 0, 0, 0); } } while (0)
#define QKTN(P0, P1, b) do { const char* Ks = lds + LK + (b) * KBYTES; \
        _Pragma("unroll") for (int d0 = 0; d0 < 4; ++d0) { const int cb = (d0 * 16 + hi * 8) * 2; \
            const bf16x8 b0 = *reinterpret_cast<const bf16x8*>(Ks + KSWZ64(r32, cb)); const bf16x8 b1 = *reinterpret_cast<const bf16x8*>(Ks + KSWZ64(32 + r32, cb)); \
            if (d0 == 0) { P0 = __builtin_amdgcn_mfma_f32_32x32x16_bf16(b0, qr[0], negm, 0, 0, 0); P1 = __builtin_amdgcn_mfma_f32_32x32x16_bf16(b1, qr[0], negm, 0, 0, 0); } \
            else { P0 = __builtin_amdgcn_mfma_f32_32x32x16_bf16(b0, qr[d0], P0, 0, 0, 0); P1 = __builtin_amdgcn_mfma_f32_32x32x16_bf16(b1, qr[d0], P1, 0, 0, 0); } } } while (0)
#define PARTIAL(P0, P1, AL) do { float pmax = P0[0]; \
        _Pragma("unroll") for (int r = 1; r < 16; ++r) pmax = fmaxf(pmax, P0[r]); \
        _Pragma("unroll") for (int r = 0; r < 16; ++r) pmax = fmaxf(pmax, P1[r]); \
        { auto rr = __builtin_amdgcn_permlane32_swap(__float_as_uint(pmax), __float_as_uint(pmax), false, false); pmax = fmaxf(__uint_as_float(rr[0]), __uint_as_float(rr[1])); } \
        float mn; if (__builtin_expect(__all(pmax - m_reg <= THR), 1)) { mn = m_reg; AL = 1.f; } else { mn = fmaxf(m_reg, pmax); AL = __builtin_amdgcn_exp2f(m_reg - mn); m_reg = mn; } \
        _Pragma("unroll") for (int r = 0; r < 16; ++r) { P0[r] = __builtin_amdgcn_exp2f(P0[r] - mn); P1[r] = P1[r] - mn; } } while (0)
#define FINISH(P0, P1, AL) do { _Pragma("unroll") for (int r = 0; r < 16; ++r) P1[r] = __builtin_amdgcn_exp2f(P1[r]); \
        float ps = 0.f; _Pragma("unroll") for (int r = 0; r < 16; ++r) ps += P0[r] + P1[r]; \
        { auto rr = __builtin_amdgcn_permlane32_swap(__float_as_uint(ps), __float_as_uint(ps), false, false); ps = __uint_as_float(rr[0]) + __uint_as_float(rr[1]); } \
        l_reg = l_reg * AL + ps; bad |= !(ps < 1e30f); PK4(P0, 0, pa0); PK4(P0, 8, pa1); PK4(P1, 0, pa2); PK4(P1, 8, pa3); } while (0)
#define PVALL(b) do { const int vb = vb0 + (b) * VBYTES; pv_one<NCB, 0>(o[0], vb, pa0, pa1, pa2, pa3); pv_one<NCB, 1>(o[1], vb, pa0, pa1, pa2, pa3); \
        pv_one<NCB, 2>(o[2], vb, pa0, pa1, pa2, pa3); pv_one<NCB, 3>(o[3], vb, pa0, pa1, pa2, pa3); } while (0)
#define PV_PARTIAL(b, P0, P1, AL) do { const int vb = vb0 + (b) * VBYTES; AL = 1.f; \
        pv_one<NCB, 0>(o[0], vb, pa0, pa1, pa2, pa3); \
        _Pragma("unroll") for (int r = 0; r < 4; ++r) P0[r] = __builtin_amdgcn_exp2f(P0[r]); \
        pv_one<NCB, 1>(o[1], vb, pa0, pa1, pa2, pa3); \
        _Pragma("unroll") for (int r = 4; r < 8; ++r) P0[r] = __builtin_amdgcn_exp2f(P0[r]); \
        pv_one<NCB, 2>(o[2], vb, pa0, pa1, pa2, pa3); \
        _Pragma("unroll") for (int r = 8; r < 12; ++r) P0[r] = __builtin_amdgcn_exp2f(P0[r]); \
        pv_one<NCB, 3>(o[3], vb, pa0, pa1, pa2, pa3); \
        _Pragma("unroll") for (int r = 12; r < 16; ++r) P0[r] = __builtin_amdgcn_exp2f(P0[r]); } while (0)
#define RESC(AL) do { if (__any((AL) < 1.f)) { if (hi == 0) al_l[r32] = (AL); asm volatile("s_waitcnt lgkmcnt(0)" ::: "memory"); \
        _Pragma("unroll") for (int d = 0; d < NCB; ++d) _Pragma("unroll") for (int r = 0; r < 16; ++r) o[d][r] *= al_l[crow(r, hi)]; } } while (0)
    f32x16 pA0, pA1, pB0, pB1; float alA, alB; bf16x8 pa0, pa1, pa2, pa3; bool bad = false;
    unsigned* flagw = (unsigned*)(lds + LWS + 2048);
    if (tid == 0) *flagw = 0u;
    if (__builtin_amdgcn_readfirstlane(wid) >= 4) __builtin_amdgcn_s_setprio(1);
    SLOAD(0); SWRITE(0); __syncthreads();
    QKT(pA0, pA1, 0); PARTIAL(pA0, pA1, alA);
    f32x16 negm;
#pragma unroll
    for (int r = 0; r < 16; ++r) negm[r] = -m_reg;
    asm volatile("" : "+v"(negm));
    SLOAD(1); SWRITE(1); __syncthreads();
#pragma unroll 1
    for (int j = 1; j + 1 < NT; j += 2) {
        SBAR(); QKTN(pB0, pB1, 1);
        FINISH(pA0, pA1, alA); SBAR();
        SLOAD(j + 1); SBAR();
        PV_PARTIAL(0, pB0, pB1, alB);
        __syncthreads(); SWRITE(0);
        __syncthreads();
        SBAR(); QKTN(pA0, pA1, 0);
        FINISH(pB0, pB1, alB); SBAR();
        SLOAD(j + 2); SBAR();
        PV_PARTIAL(1, pA0, pA1, alA);
        __syncthreads(); SWRITE(1);
        __syncthreads();
    }
    SBAR(); QKTN(pB0, pB1, 1);
    FINISH(pA0, pA1, alA); SBAR();
    PV_PARTIAL(0, pB0, pB1, alB);
    FINISH(pB0, pB1, alB); SBAR();
    PVALL(1);
    __builtin_amdgcn_s_setprio(0);
    if (__any(bad) && lane == 0) *flagw = 1u;
    __syncthreads();
    const bool ok = (*flagw == 0u);
    __syncthreads();
#undef KROW
#undef SLOAD
#undef SWRITE
#undef QKT
#undef PARTIAL
#undef FINISH
#undef PVALL
#undef PV_PARTIAL
#undef RESC
#undef QKTN
    return ok;
}

template <int DV>
__device__ __forceinline__ void attn_core_sm(int wv__, char* lds, const CoreArgs& A, f32x16 (&o)[DV / 32], float& l_reg) {
    constexpr int NCB = DV / 32, VBYTES = 64 * DV * 2, KBYTES = 8192; constexpr float THR = 8.f;
    static_assert(DV == 128, "softmax core is written for 128 value columns");
    int tid = TIDX(); asm volatile("" : "+v"(tid));
    const int wid = tid >> 6, lane = tid & 63, r32 = lane & 31, hi = lane >> 5;
    float* al_l = (float*)(lds + LWS) + wid * 64;
    const int NT = A.nt_a + A.nt_b;
    bf16x8 qr[4];
    { const bf16* Qw = A.P + (size_t)(A.qrow + wid * 32 + r32) * INW + A.qcol + hi * 8;
#pragma unroll
      for (int d0 = 0; d0 < 4; ++d0) qr[d0] = *reinterpret_cast<const bf16x8*>(Qw + d0 * 16); }
#pragma unroll
    for (int d = 0; d < NCB; ++d) o[d] = f32x16{};
    float m_reg = -1e30f; l_reg = 0.f;
    const int kr = tid >> 3, kc = (tid & 7) * 8;
    const int kdst = KSWZ64(kr, kc * 2);
    const int vr0 = tid >> 4, vc0 = (tid & 15) * 8, vdst0 = v_st<NCB>(vr0, vc0), vdst1 = v_st<NCB>(vr0 + 32, vc0);
    const int vb0 = (int)(uintptr_t)(lds + LV) + v_rd_base(lane);
    bf16x8 sk, sv0, sv1;
#define KROW(t) ((t) < A.nt_a ? A.kr_a + 64 * (t) : A.kr_b + 64 * ((t) - A.nt_a))
#define SLOAD(t) do { const long kb_ = KROW(t); sk = *reinterpret_cast<const bf16x8*>(A.P + (size_t)(kb_ + kr) * INW + A.kcol + kc); \
        sv0 = *reinterpret_cast<const bf16x8*>(A.P + (size_t)(kb_ + vr0) * INW + A.vcol + vc0); \
        sv1 = *reinterpret_cast<const bf16x8*>(A.P + (size_t)(kb_ + vr0 + 32) * INW + A.vcol + vc0); } while (0)
#define SWRITE(b) do { *(bf16x8*)(lds + LK + (b) * KBYTES + kdst) = sk; *(bf16x8*)(lds + LV + (b) * VBYTES + vdst0) = sv0; \
        *(bf16x8*)(lds + LV + (b) * VBYTES + vdst1) = sv1; } while (0)
#define QKT(P0, P1, b) do { const char* Ks = lds + LK + (b) * KBYTES; P0 = f32x16{}; P1 = f32x16{}; \
        _Pragma("unroll") for (int d0 = 0; d0 < 4; ++d0) { const int cb = (d0 * 16 + hi * 8) * 2; \
            const bf16x8 b0 = *reinterpret_cast<const bf16x8*>(Ks + KSWZ64(r32, cb)); const bf16x8 b1 = *reinterpret_cast<const bf16x8*>(Ks + KSWZ64(32 + r32, cb)); \
            P0 = __builtin_amdgcn_mfma_f32_32x32x16_bf16(b0, qr[d0], P0, 0, 0, 0); P1 = __builtin_amdgcn_mfma_f32_32x32x16_bf16(b1, qr[d0], P1, 0, 0, 0); } } while (0)
#define PARTIAL(P0, P1, AL) do { float pmax = P0[0]; \
        _Pragma("unroll") for (int r = 1; r < 16; ++r) pmax = fmaxf(pmax, P0[r]); \
        _Pragma("unroll") for (int r = 0; r < 16; ++r) pmax = fmaxf(pmax, P1[r]); \
        { auto rr = __builtin_amdgcn_permlane32_swap(__float_as_uint(pmax), __float_as_uint(pmax), false, false); pmax = fmaxf(__uint_as_float(rr[0]), __uint_as_float(rr[1])); } \
        float mn; if (__builtin_expect(__all(pmax - m_reg <= THR), 1)) { mn = m_reg; AL = 1.f; } else { mn = fmaxf(m_reg, pmax); AL = __builtin_amdgcn_exp2f(m_reg - mn); m_reg = mn; } \
        _Pragma("unroll") for (int r = 0; r < 16; ++r) { P0[r] = __builtin_amdgcn_exp2f(P0[r] - mn); P1[r] = P1[r] - mn; } } while (0)
#define FINISH(P0, P1, AL) do { _Pragma("unroll") for (int r = 0; r < 16; ++r) P1[r] = __builtin_amdgcn_exp2f(P1[r]); \
        float ps = 0.f; _Pragma("unroll") for (int r = 0; r < 16; ++r) ps += P0[r] + P1[r]; \
        { auto rr = __builtin_amdgcn_permlane32_swap(__float_as_uint(ps), __float_as_uint(ps), false, false); ps = __uint_as_float(rr[0]) + __uint_as_float(rr[1]); } \
        l_reg = l_reg * AL + ps; PK4(P0, 0, pa0); PK4(P0, 8, pa1); PK4(P1, 0, pa2); PK4(P1, 8, pa3); } while (0)
#define PVALL(b) do { const int vb = vb0 + (b) * VBYTES; pv_one<NCB, 0>(o[0], vb, pa0, pa1, pa2, pa3); pv_one<NCB, 1>(o[1], vb, pa0, pa1, pa2, pa3); \
        pv_one<NCB, 2>(o[2], vb, pa0, pa1, pa2, pa3); pv_one<NCB, 3>(o[3], vb, pa0, pa1, pa2, pa3); } while (0)
#define PV_PARTIAL(b, P0, P1, AL) do { const int vb = vb0 + (b) * VBYTES; float pm0, pm1, mn; \
        pv_one<NCB, 0>(o[0], vb, pa0, pa1, pa2, pa3); \
        pm0 = fmaxf(P0[0], P0[1]); _Pragma("unroll") for (int r = 2; r < 16; ++r) pm0 = fmaxf(pm0, P0[r]); \
        pv_one<NCB, 1>(o[1], vb, pa0, pa1, pa2, pa3); \
        pm1 = fmaxf(P1[0], P1[1]); _Pragma("unroll") for (int r = 2; r < 16; ++r) pm1 = fmaxf(pm1, P1[r]); pm0 = fmaxf(pm0, pm1); \
        { auto rr = __builtin_amdgcn_permlane32_swap(__float_as_uint(pm0), __float_as_uint(pm0), false, false); pm0 = fmaxf(__uint_as_float(rr[0]), __uint_as_float(rr[1])); } \
        if (__builtin_expect(__all(pm0 - m_reg <= THR), 1)) { mn = m_reg; AL = 1.f; } else { mn = fmaxf(m_reg, pm0); AL = __builtin_amdgcn_exp2f(m_reg - mn); m_reg = mn; } \
        pv_one<NCB, 2>(o[2], vb, pa0, pa1, pa2, pa3); \
        _Pragma("unroll") for (int r = 0; r < 8; ++r) P0[r] = __builtin_amdgcn_exp2f(P0[r] - mn); \
        _Pragma("unroll") for (int r = 0; r < 16; ++r) P1[r] = P1[r] - mn; \
        pv_one<NCB, 3>(o[3], vb, pa0, pa1, pa2, pa3); \
        _Pragma("unroll") for (int r = 8; r < 16; ++r) P0[r] = __builtin_amdgcn_exp2f(P0[r] - mn); } while (0)
#define RESC(AL) do { if (__any((AL) < 1.f)) { if (hi == 0) al_l[r32] = (AL); asm volatile("s_waitcnt lgkmcnt(0)" ::: "memory"); \
        _Pragma("unroll") for (int d = 0; d < NCB; ++d) _Pragma("unroll") for (int r = 0; r < 16; ++r) o[d][r] *= al_l[crow(r, hi)]; } } while (0)
    f32x16 pA0, pA1, pB0, pB1; float alA, alB; bf16x8 pa0, pa1, pa2, pa3;
    SLOAD(0); SWRITE(0); __syncthreads();
    QKT(pA0, pA1, 0); PARTIAL(pA0, pA1, alA);
    SLOAD(1); SWRITE(1); __syncthreads();
#pragma unroll 1
    for (int j = 1; j + 1 < NT; j += 2) {
        SBAR(); QKT(pB0, pB1, 1);
        FINISH(pA0, pA1, alA); SBAR();
        SLOAD(j + 1); SBAR();
        PV_PARTIAL(0, pB0, pB1, alB);
        __syncthreads(); SWRITE(0);
        RESC(alB); __syncthreads();
        SBAR(); QKT(pA0, pA1, 0);
        FINISH(pB0, pB1, alB); SBAR();
        SLOAD(j + 2); SBAR();
        PV_PARTIAL(1, pA0, pA1, alA);
        __syncthreads(); SWRITE(1);
        RESC(alA); __syncthreads();
    }
    SBAR(); QKT(pB0, pB1, 1);
    FINISH(pA0, pA1, alA); SBAR();
    PV_PARTIAL(0, pB0, pB1, alB);
    RESC(alB);
    FINISH(pB0, pB1, alB); SBAR();
    PVALL(1);
    __syncthreads();
#undef KROW
#undef SLOAD
#undef SWRITE
#undef QKT
#undef PARTIAL
#undef FINISH
#undef PVALL
#undef PV_PARTIAL
#undef RESC
}
__device__ __forceinline__ void diff_unit(int wv__, char* lds, const bf16* P, bf16* MIX, float* scr  , const float* gnw  ,
                                          float lam, float lam_init, long qrow, long kr_a, int nt_a, long kr_b, int nt_b, int h) {
    int tid = TIDX(); asm volatile("" : "+v"(tid));
    const int wid = tid >> 6, lane = tid & 63, r32 = lane & 31, hi = lane >> 5;
    float* al_l = (float*)(lds + LWS) + wid * 64;
    CoreArgs A; A.P = P; A.qrow = qrow; A.vcol = 2048 + 128 * h;
    A.kr_a = kr_a; A.nt_a = nt_a; A.kr_b = kr_b; A.nt_b = nt_b; A.ipos0 = 0; A.lf = 0.f; A.lb = 0.f;
    {
        A.qcol = 1024 + 64 * (2 * h); A.kcol = 1536 + 64 * (2 * h);
        f32x16 o[4]; float l_reg;
        if (!attn_core_fast<128>(wv__, lds, A, o, l_reg)) attn_core_sm<128>(wv__, lds, A, o, l_reg);
        if (hi == 0) al_l[r32] = l_reg; asm volatile("s_waitcnt lgkmcnt(0)" ::: "memory");
        f32x4* sp = (f32x4*)scr + (size_t)(wid * 1024 + lane);
#pragma unroll
        for (int r = 0; r < 16; ++r) { const float rl = __builtin_amdgcn_rcpf(al_l[crow(r, hi)]);
            sp[r * 64] = (f32x4){o[0][r] * rl, o[1][r] * rl, o[2][r] * rl, o[3][r] * rl}; }
        __syncthreads();
    }
    {
        A.qcol = 1024 + 64 * (2 * h + 1); A.kcol = 1536 + 64 * (2 * h + 1);
        f32x16 o[4]; float l_reg;
        if (!attn_core_fast<128>(wv__, lds, A, o, l_reg)) attn_core_sm<128>(wv__, lds, A, o, l_reg);
        if (hi == 0) al_l[r32] = l_reg; asm volatile("s_waitcnt lgkmcnt(0)" ::: "memory");
        const f32x4* sp = (const f32x4*)scr + (size_t)(wid * 1024 + lane);
        float w4[4];
#pragma unroll
        for (int d = 0; d < 4; ++d) w4[d] = gnw[h * 128 + 32 * d + r32] * (1.f - lam_init);
        f32x4 s0a[16];
#pragma unroll
        for (int r = 0; r < 16; ++r) s0a[r] = sp[r * 64];
#pragma unroll
        for (int r = 0; r < 16; ++r) {
            const float rl = lam * __builtin_amdgcn_rcpf(al_l[crow(r, hi)]);
            float v[4]; float ss = 0.f; const f32x4 s0 = s0a[r];
#pragma unroll
            for (int d = 0; d < 4; ++d) { v[d] = s0[d] - o[d][r] * rl; ss += v[d] * v[d]; }
            const float rs = __builtin_amdgcn_rsqf(half_sum32(ss) * (1.f / 128.f) + EPSN);
            bf16* mp = MIX + (size_t)(qrow + wid * 32 + crow(r, hi)) * DM + 256 + h * 128 + r32;
#pragma unroll
            for (int d = 0; d < 4; ++d) mp[32 * d] = (bf16)f2bf(v[d] * rs * w4[d]);
            if ((r & 1) == 1) asm volatile("" ::: "memory");
        }
        __syncthreads();
    }
}
__device__ __forceinline__ void ret_epilogue(f32x16 (&o)[2], const bf16* P, bf16* MIX, const float* gnw, long qrow, int wid, int r32, int hi, int h) {
    unsigned short gq[2][16];
#pragma unroll
    for (int d = 0; d < 2; ++d)
#pragma unroll
        for (int r = 0; r < 16; ++r) gq[d][r] = P[(size_t)(qrow + wid * 32 + crow(r, hi)) * INW + 768 + 64 * h + 32 * d + r32];
    float mu[16], rs[16];
#pragma unroll
    for (int r = 0; r < 16; ++r) mu[r] = half_sum32(o[0][r] + o[1][r]) * (1.f / 64.f);
#pragma unroll
    for (int r = 0; r < 16; ++r) { const float a = o[0][r] - mu[r], b = o[1][r] - mu[r]; o[0][r] = a; o[1][r] = b; rs[r] = __builtin_amdgcn_rsqf(half_sum32(a * a + b * b) * (1.f / 64.f) + EPSN); }
#pragma unroll
    for (int d = 0; d < 2; ++d) { const float w = gnw[h * 64 + 32 * d + r32];
#pragma unroll
        for (int r = 0; r < 16; ++r) { const size_t row = (size_t)(qrow + wid * 32 + crow(r, hi));
            const float g = bf2f(gq[d][r]);
            MIX[row * DM + 64 * h + 32 * d + r32] = (bf16)f2bf(o[d][r] * rs[r] * w * g); } }
}
template <int KS> __device__ __forceinline__ bf16x8 tr_frag(int base) {
    const s16x4 l = tr_read<KS * 2048>(base), hh = tr_read<KS * 2048 + 1024>(base);
    return (bf16x8){l[0], l[1], l[2], l[3], hh[0], hh[1], hh[2], hh[3]};
}
__device__ __forceinline__ bf16x8 scale8(bf16x8 v, float c) {
    const v4u u = __builtin_bit_cast(v4u, v); v4u o;
    o.x = pk2(__uint_as_float(u.x << 16) * c, __uint_as_float(u.x & 0xffff0000u) * c); o.y = pk2(__uint_as_float(u.y << 16) * c, __uint_as_float(u.y & 0xffff0000u) * c);
    o.z = pk2(__uint_as_float(u.z << 16) * c, __uint_as_float(u.z & 0xffff0000u) * c); o.w = pk2(__uint_as_float(u.w << 16) * c, __uint_as_float(u.w & 0xffff0000u) * c);
    return __builtin_bit_cast(bf16x8, o);
}
__device__ __forceinline__ void ret_unit_state(int wv__, char* lds, const bf16* P, bf16* MIX, const float* gnw, float lf, float lb, int b, int blk, int h) {
    int tid = TIDX(); asm volatile("" : "+v"(tid));
    const int wid = tid >> 6, lane = tid & 63, r32 = lane & 31, hi = lane >> 5;
    const int i0 = blk * 256; const long qrow = (long)b * SEQ + i0;
    const int kcol = 256 + 64 * h, vcol = 512 + 64 * h;
    constexpr int STG = 49152, OVF = 16384, OVB = 32768;
    constexpr int LSF = 98304, LSB = 106496, LRED = 114688;
    const int srow = tid >> 3, sc8 = (tid & 7) * 8;
    const int sdst = v_st<2>(srow, sc8);
    const int d0 = wid & 1, n0 = (wid >> 1) & 1, kh = wid >> 2;
    const int vbase = (int)(uintptr_t)lds + v_rd_base(lane);
    f32x16 accf = f32x16{}, accb = f32x16{};
    bf16x8 rk0, rk1, rv0, rv1; float cf0, cb0, cf1, cb1;
#define FAR_LOAD(s) do { long kb_; int j_; const bool ctx_ = (s) >= 14; \
        if (!ctx_) { const int pp = (s) < 2 * blk ? (s) : (s) + 2; kb_ = (long)b * SEQ + 128 * pp; j_ = 128 * pp; } else { kb_ = (long)NLAT + (long)b * CTXL + 128 * ((s) - 14); j_ = 128 * ((s) - 14); } \
        const bf16* r0_ = P + (size_t)(kb_ + srow) * INW; const bf16* r1_ = r0_ + (size_t)64 * INW; \
        rk0 = *(const bf16x8*)(r0_ + kcol + sc8); rv0 = *(const bf16x8*)(r0_ + vcol + sc8); rk1 = *(const bf16x8*)(r1_ + kcol + sc8); rv1 = *(const bf16x8*)(r1_ + vcol + sc8); \
        const int ja = j_ + srow, jb = ja + 64; \
        if (ctx_) { cf0 = __builtin_amdgcn_exp2f(lf * (float)(i0 + CTXL - ja)); cb0 = __builtin_amdgcn_exp2f(lb * (float)(SEQ + ja - i0 - 255)); \
                    cf1 = __builtin_amdgcn_exp2f(lf * (float)(i0 + CTXL - jb)); cb1 = __builtin_amdgcn_exp2f(lb * (float)(SEQ + jb - i0 - 255)); } \
        else { const bool bel = ja < i0; cf0 = bel ? __builtin_amdgcn_exp2f(lf * (float)(i0 - ja)) : 0.f; cb0 = bel ? 0.f : __builtin_amdgcn_exp2f(lb * (float)(ja - i0 - 255)); \
               cf1 = bel ? __builtin_amdgcn_exp2f(lf * (float)(i0 - jb)) : 0.f; cb1 = bel ? 0.f : __builtin_amdgcn_exp2f(lb * (float)(jb - i0 - 255)); } } while (0)
#define FAR_WRITE(bf) do { char* sb_ = lds + (bf) * STG + sdst; \
        *(bf16x8*)(sb_) = rk0; *(bf16x8*)(sb_ + 8192) = rk1; \
        *(bf16x8*)(sb_ + OVF) = scale8(rv0, cf0); *(bf16x8*)(sb_ + OVF + 8192) = scale8(rv1, cf1); \
        *(bf16x8*)(sb_ + OVB) = scale8(rv0, cb0); *(bf16x8*)(sb_ + OVB + 8192) = scale8(rv1, cb1); } while (0)
#define FAR_STEP(KS) do { const bf16x8 a_ = tr_frag<KS>(ka_), f_ = tr_frag<KS>(fa_), g_ = tr_frag<KS>(ga_); asm volatile("s_waitcnt lgkmcnt(0)" ::: "memory"); SBAR(); \
        accf = __builtin_amdgcn_mfma_f32_32x32x16_bf16(a_, f_, accf, 0, 0, 0); accb = __builtin_amdgcn_mfma_f32_32x32x16_bf16(a_, g_, accb, 0, 0, 0); } while (0)
    FAR_LOAD(0); FAR_WRITE(0); __syncthreads();
#pragma unroll 1
    for (int s = 0; s < 16; ++s) {
        const int buf = s & 1;
        if (s + 1 < 16) FAR_LOAD(s + 1);
        { const int ka_ = vbase + buf * STG + kh * 8192 + d0 * 512, fa_ = vbase + buf * STG + OVF + kh * 8192 + n0 * 512, ga_ = vbase + buf * STG + OVB + kh * 8192 + n0 * 512;
          FAR_STEP(0); FAR_STEP(1); FAR_STEP(2); FAR_STEP(3); }
        if (s + 1 < 16) FAR_WRITE(buf ^ 1);
        __syncthreads();
    }
#undef FAR_LOAD
#undef FAR_WRITE
#undef FAR_STEP
    { float* red = (float*)(lds + LRED);
      if (wid >= 4) {
#pragma unroll
          for (int r = 0; r < 16; ++r) { red[((wid - 4) * 2 + 0) * 1024 + r * 64 + lane] = accf[r]; red[((wid - 4) * 2 + 1) * 1024 + r * 64 + lane] = accb[r]; } }
      __syncthreads();
      if (wid < 4) {
#pragma unroll
          for (int r = 0; r < 16; ++r) { const float sf = accf[r] + red[(wid * 2 + 0) * 1024 + r * 64 + lane], sb = accb[r] + red[(wid * 2 + 1) * 1024 + r * 64 + lane];
              const int off = v_st<2>(32 * d0 + crow(r, hi), 32 * n0 + r32);
              *(bf16*)(lds + LSF + off) = (bf16)f2bf(sf); *(bf16*)(lds + LSB + off) = (bf16)f2bf(sb); } }
      __syncthreads(); }
    CoreArgs A; A.P = P; A.qrow = qrow; A.qcol = 64 * h; A.kcol = kcol; A.vcol = vcol;
    A.kr_a = qrow; A.nt_a = 4; A.kr_b = 0; A.nt_b = 0; A.ipos0 = 0; A.lf = lf; A.lb = lb;
    f32x16 o[2]; float l_reg;
    attn_core<64, 1>(wv__, lds, A, o, l_reg);
    { const int iqr = wid * 32 + r32;
      const bf16* Qp = P + (size_t)(qrow + iqr) * INW + 64 * h + 4 * hi;
      float x0[16], x1[16];
#pragma unroll
      for (int g = 0; g < 4; ++g) { const v2u a = *(const v2u*)(Qp + 8 * g), c = *(const v2u*)(Qp + 32 + 8 * g);
          x0[4 * g + 0] = __uint_as_float(a.x << 16); x0[4 * g + 1] = __uint_as_float(a.x & 0xffff0000u); x0[4 * g + 2] = __uint_as_float(a.y << 16); x0[4 * g + 3] = __uint_as_float(a.y & 0xffff0000u);
          x1[4 * g + 0] = __uint_as_float(c.x << 16); x1[4 * g + 1] = __uint_as_float(c.x & 0xffff0000u); x1[4 * g + 2] = __uint_as_float(c.y << 16); x1[4 * g + 3] = __uint_as_float(c.y & 0xffff0000u); }
      const float af = __builtin_amdgcn_exp2f(lf * (float)iqr), ab = __builtin_amdgcn_exp2f(lb * (float)(255 - iqr));
      float y0[16], y1[16]; bf16x8 pa0, pa1, pa2, pa3;
#pragma unroll
      for (int r = 0; r < 16; ++r) { y0[r] = x0[r] * af; y1[r] = x1[r] * af; }
      PK4(y0, 0, pa0); PK4(y0, 8, pa1); PK4(y1, 0, pa2); PK4(y1, 8, pa3); SBAR();
      pv_one<2, 0>(o[0], vbase + LSF, pa0, pa1, pa2, pa3); pv_one<2, 1>(o[1], vbase + LSF, pa0, pa1, pa2, pa3);
#pragma unroll
      for (int r = 0; r < 16; ++r) { y0[r] = x0[r] * ab; y1[r] = x1[r] * ab; }
      PK4(y0, 0, pa0); PK4(y0, 8, pa1); PK4(y1, 0, pa2); PK4(y1, 8, pa3); SBAR();
      pv_one<2, 0>(o[0], vbase + LSB, pa0, pa1, pa2, pa3); pv_one<2, 1>(o[1], vbase + LSB, pa0, pa1, pa2, pa3); }
    ret_epilogue(o, P, MIX, gnw, qrow, wid, r32, hi, h);
    __syncthreads();
}
__device__ __forceinline__ void ret_unit(int wv__, char* lds, const bf16* P, bf16* MIX, const float* gnw  , float lf, float lb,
                                         long qrow, int ipos0, long kr_a, int nt_a, long kr_b, int nt_b, int h) {
    int tid = TIDX(); asm volatile("" : "+v"(tid));
    const int wid = tid >> 6, lane = tid & 63, r32 = lane & 31, hi = lane >> 5;
    CoreArgs A; A.P = P; A.qrow = qrow; A.qcol = 64 * h; A.kcol = 256 + 64 * h; A.vcol = 512 + 64 * h;
    A.kr_a = kr_a; A.nt_a = nt_a; A.kr_b = kr_b; A.nt_b = nt_b; A.ipos0 = ipos0; A.lf = lf; A.lb = lb;
    f32x16 o[2]; float l_reg;
    attn_core<64, 1>(wv__, lds, A, o, l_reg);
    ret_epilogue(o, P, MIX, gnw, qrow, wid, r32, hi, h);
    __syncthreads();
}
#undef SBAR
}

__device__ __forceinline__ void conv_unit(int wv__, char* lds, const bf16* P, bf16* MIX, const float* cw  , const float* cb, const float* lnw, const float* lnb,
                                          long seqrow  , int L, int t0) {
    int tid = TIDX(); asm volatile("" : "+v"(tid));
    const int wid = tid >> 6, lane = tid & 63;
    bf16* ub = (bf16*)lds;
    float* yb = (float*)(lds + 49152);
    for (int i = tid; i < 94 * 32; i += 512) { const int rr = i >> 5, ch = (i & 31) * 8; const int t = t0 - 15 + rr;
        v4u v = {0u, 0u, 0u, 0u};
        if (t >= 0 && t < L) v = *(const v4u*)(P + (size_t)(seqrow + t) * INW + 2560 + ch);
        *(v4u*)(ub + rr * 256 + ch) = v; }
    __syncthreads();
    { const int c = tid & 255, hf = tid >> 8;
      float w[31];
#pragma unroll
      for (int k = 0; k < 31; ++k) w[k] = cw[k * 256 + c];
      const float bias = cb[c];
#pragma unroll
      for (int g = 0; g < 4; ++g) {
          float uv[38];
#pragma unroll
          for (int k = 0; k < 38; ++k) uv[k] = bf2f(ub[(hf * 32 + g * 8 + k) * 256 + c]);
#pragma unroll
          for (int tt = 0; tt < 8; ++tt) { float a = bias;
#pragma unroll
              for (int k = 0; k < 31; ++k) a += uv[tt + k] * w[k];
              yb[(hf * 32 + g * 8 + tt) * 256 + c] = a; }
      } }
    __syncthreads();
    { const f32x4 lw = *(const f32x4*)(lnw + lane * 4), lb = *(const f32x4*)(lnb + lane * 4);
#pragma unroll 1
      for (int i = 0; i < 8; ++i) { const int tok = wid * 8 + i;
        f32x4 v = *(const f32x4*)(yb + tok * 256 + lane * 4);
        const float mean = wave_sum((v.x + v.y) + (v.z + v.w)) * (1.f / 256.f);
        v = v - mean;
        const float rstd = __builtin_amdgcn_rsqf(wave_sum((v.x * v.x + v.y * v.y) + (v.z * v.z + v.w * v.w)) * (1.f / 256.f) + EPSN);
        v = v * rstd * lw + lb;
        v.x *= fast_sigmoid(v.x); v.y *= fast_sigmoid(v.y); v.z *= fast_sigmoid(v.z); v.w *= fast_sigmoid(v.w);
        v2u o; o.x = pk2(v.x, v.y); o.y = pk2(v.z, v.w);
        *(v2u*)(MIX + (size_t)(seqrow + t0 + tok) * DM + 768 + lane * 4) = o; } }
    __syncthreads();
}

__device__ __forceinline__ void norm_mod_rows(int wv__, const float* xl, const float* xc, const float* w, const float* modl, int si, int sci, bf16* XN, int nrows, int vcu, int NGW) {
    int tid_ = TIDX(); asm volatile("" : "+v"(tid_)); const int lane = tid_ & 63, gw = vcu * 8 + __builtin_amdgcn_readfirstlane(tid_ >> 6);
    f32x4 wv[4];
#pragma unroll
    for (int j = 0; j < 4; ++j) wv[j] = *(const f32x4*)(w + 256 * j + 4 * lane);
    for (int row0 = gw; row0 < nrows; row0 += 2 * NGW) {
        const int row1 = row0 + NGW; const bool has1 = row1 < nrows; const int r1 = has1 ? row1 : row0;
        const bool lat0 = row0 < NLAT, lat1 = r1 < NLAT;
        const float* x0 = lat0 ? xl + (size_t)row0 * DM : xc + (size_t)(row0 - NLAT) * DM;
        const float* x1 = lat1 ? xl + (size_t)r1 * DM : xc + (size_t)(r1 - NLAT) * DM;
        const float* mb0 = modl + (size_t)(lat0 ? (row0 >> 11) : 16) * NMODW; const float* mb1 = modl + (size_t)(lat1 ? (r1 >> 11) : 16) * NMODW;
        f32x4 v0[4], v1[4]; float s0 = 0.f, s1 = 0.f;
#pragma unroll
        for (int j = 0; j < 4; ++j) { v0[j] = __builtin_nontemporal_load((const f32x4*)(x0 + 256 * j + 4 * lane)); v1[j] = __builtin_nontemporal_load((const f32x4*)(x1 + 256 * j + 4 * lane)); }
#pragma unroll
        for (int j = 0; j < 4; ++j) { s0 += (v0[j].x * v0[j].x + v0[j].y * v0[j].y) + (v0[j].z * v0[j].z + v0[j].w * v0[j].w); s1 += (v1[j].x * v1[j].x + v1[j].y * v1[j].y) + (v1[j].z * v1[j].z + v1[j].w * v1[j].w); }
#pragma unroll
        for (int o = 1; o < 64; o <<= 1) { s0 += __shfl_xor(s0, o); s1 += __shfl_xor(s1, o); }
        const float rs0 = __builtin_amdgcn_rsqf(s0 * (1.f / DM) + EPSN), rs1 = __builtin_amdgcn_rsqf(s1 * (1.f / DM) + EPSN);
#pragma unroll
        for (int j = 0; j < 4; ++j) { const int c = 256 * j + 4 * lane;
            { const f32x4 y = v0[j] * rs0 * wv[j] * (*(const f32x4*)(mb0 + sci * DM + c) + 1.f) + *(const f32x4*)(mb0 + si * DM + c);
              v2u o; o.x = pk2(y.x, y.y); o.y = pk2(y.z, y.w); *(v2u*)(XN + (size_t)row0 * DM + c) = o; }
            if (has1) { const f32x4 y = v1[j] * rs1 * wv[j] * (*(const f32x4*)(mb1 + sci * DM + c) + 1.f) + *(const f32x4*)(mb1 + si * DM + c);
              v2u o; o.x = pk2(y.x, y.y); o.y = pk2(y.z, y.w); *(v2u*)(XN + (size_t)row1 * DM + c) = o; } }
    }
}
__device__ __forceinline__ void final_norm_rows(int wv__, float* x, const float* w, int vcu, int NGW) {
    int tid_ = TIDX(); asm volatile("" : "+v"(tid_)); const int lane = tid_ & 63, gw = vcu * 8 + __builtin_amdgcn_readfirstlane(tid_ >> 6);
    f32x4 wv[4];
#pragma unroll
    for (int j = 0; j < 4; ++j) wv[j] = *(const f32x4*)(w + 256 * j + 4 * lane);
    for (int row = gw; row < NLAT; row += 2 * NGW) {
        float* x0 = x + (size_t)row * DM; float* x1 = x + (size_t)(row + NGW) * DM; f32x4 v0[4], v1[4]; float s0 = 0.f, s1 = 0.f;
#pragma unroll
        for (int j = 0; j < 4; ++j) { v0[j] = *(const f32x4*)(x0 + 256 * j + 4 * lane); v1[j] = *(const f32x4*)(x1 + 256 * j + 4 * lane); }
#pragma unroll
        for (int j = 0; j < 4; ++j) { s0 += (v0[j].x * v0[j].x + v0[j].y * v0[j].y) + (v0[j].z * v0[j].z + v0[j].w * v0[j].w); s1 += (v1[j].x * v1[j].x + v1[j].y * v1[j].y) + (v1[j].z * v1[j].z + v1[j].w * v1[j].w); }
#pragma unroll
        for (int o = 1; o < 64; o <<= 1) { s0 += __shfl_xor(s0, o); s1 += __shfl_xor(s1, o); }
        const float rs0 = __builtin_amdgcn_rsqf(s0 * (1.f / DM) + EPSN), rs1 = __builtin_amdgcn_rsqf(s1 * (1.f / DM) + EPSN);
#pragma unroll
        for (int j = 0; j < 4; ++j) { *(f32x4*)(x0 + 256 * j + 4 * lane) = v0[j] * rs0 * wv[j]; *(f32x4*)(x1 + 256 * j + 4 * lane) = v1[j] * rs1 * wv[j]; }
    }
}
__device__ __forceinline__ void ctx_combine(int wv__, float* CTXRES, const float* part0, const float* part1, const float* gate, const float* nw, const float* sc, bf16* XNc, float* rowsqc, int vcu, int NGW) {
    int tid_ = TIDX(); asm volatile("" : "+v"(tid_)); const int lane = tid_ & 63, gw = vcu * 8 + __builtin_amdgcn_readfirstlane(tid_ >> 6);
    f32x4 gv[4], mv[4];
#pragma unroll
    for (int j = 0; j < 4; ++j) { const int c = 256 * j + 4 * lane; gv[j] = *(const f32x4*)(gate + c); mv[j] = *(const f32x4*)(nw + c) * (*(const f32x4*)(sc + c) + 1.f); }
    for (int row = gw; row < NCTX; row += NGW) {
        f32x4 a0[4], a1[4], a2[4], a3[4], cr[4];
#pragma unroll
        for (int j = 0; j < 4; ++j) { const size_t off = (size_t)row * DM + 256 * j + 4 * lane;
            a0[j] = __builtin_nontemporal_load((const f32x4*)(part0 + off)); a1[j] = __builtin_nontemporal_load((const f32x4*)(part0 + (size_t)NCTX * DM + off)); a2[j] = __builtin_nontemporal_load((const f32x4*)(part1 + off)); a3[j] = __builtin_nontemporal_load((const f32x4*)(part1 + (size_t)NCTX * DM + off));
            cr[j] = *(const f32x4*)(CTXRES + off); }
        float ss = 0.f;
#pragma unroll
        for (int j = 0; j < 4; ++j) { const size_t off = (size_t)row * DM + 256 * j + 4 * lane;
            const f32x4 x = cr[j] + gv[j] * ((a0[j] + a1[j]) + (a2[j] + a3[j]));
            *(f32x4*)(CTXRES + off) = x; ss += (x.x * x.x + x.y * x.y) + (x.z * x.z + x.w * x.w);
            const f32x4 y = x * mv[j];
            v2u o; o.x = pk2(y.x, y.y); o.y = pk2(y.z, y.w); *(v2u*)(XNc + off) = o; }
        ss = wave_sum(ss);
        if (lane == 0) rowsqc[row] = ss;
    }
}
template <bool PERMIN>
__device__ __forceinline__ void p0_transpose_item(const float* W, int K, int N, bf16* WT, LAS float* scr, int item, int lane) {
    const int nblk = N / 32, kb = item / nblk, nb = item % nblk, k0 = 64 * kb, n0 = 32 * nb;
    const int src = PERMIN ? win_src_col(n0 + (lane & 31)) : n0 + (lane & 31);
    { float t[32];
#pragma unroll
      for (int i = 0; i < 32; ++i) t[i] = __builtin_nontemporal_load(W + (size_t)(k0 + 2 * i + (lane >> 5)) * N + src);
#pragma unroll
      for (int i = 0; i < 32; ++i) scr[(2 * i + (lane >> 5)) * 33 + (lane & 31)] = t[i]; }
    asm volatile("s_waitcnt lgkmcnt(0)" ::: "memory");
    const int c = lane & 7;
#pragma unroll
    for (int j = 0; j < 4; ++j) { const int n = (lane >> 3) + 8 * j; const LAS float* s = scr + (8 * c) * 33 + n;
        v4u o; o.x = pk2(s[0 * 33], s[1 * 33]); o.y = pk2(s[2 * 33], s[3 * 33]); o.z = pk2(s[4 * 33], s[5 * 33]); o.w = pk2(s[6 * 33], s[7 * 33]);
        *(v4u*)(WT + (size_t)(n0 + n) * K + k0 + 8 * c) = o; }
    asm volatile("s_waitcnt lgkmcnt(0)" ::: "memory");
}
__device__ __forceinline__ void mod_unit(int wv__, char* lds, const float* c, const float* cctx, const float* adaw, const float* adab, float* MOD, int l, int nb) {
    int tid = TIDX(); asm volatile("" : "+v"(tid));
    const int wid = tid >> 6, lane = tid & 63;
    float* sil = (float*)lds;
    float* red = (float*)(lds + 69632);
    { float t[34];
#pragma unroll
      for (int j = 0; j < 34; ++j) { const int i = tid + 512 * j, r = i >> 10, k = i & 1023; t[j] = (r < 16) ? c[r * 1024 + k] : cctx[k]; }
#pragma unroll
      for (int j = 0; j < 34; ++j) sil[tid + 512 * j] = t[j] * fast_sigmoid(t[j]); }
    __syncthreads();
    const int n0 = nb * 64;
    const float* wp = adaw + (size_t)l * DM * NMODW + n0 + lane;
    float acc[17];
#pragma unroll
    for (int r = 0; r < 17; ++r) acc[r] = 0.f;
#pragma unroll 1
    for (int kb = 0; kb < 128; kb += 32) {
        float wv[32];
#pragma unroll
        for (int j = 0; j < 32; ++j) wv[j] = __builtin_nontemporal_load(wp + (size_t)(wid * 128 + kb + j) * NMODW);
#pragma unroll
        for (int j = 0; j < 32; ++j) { const int k = wid * 128 + kb + j;
#pragma unroll
            for (int r = 0; r < 17; ++r) acc[r] += sil[r * 1024 + k] * wv[j]; } }
#pragma unroll
    for (int r = 0; r < 17; ++r) red[(wid * 17 + r) * 64 + lane] = acc[r];
    __syncthreads();
    for (int i = tid; i < 17 * 64; i += 512) { const int r = i >> 6, n = i & 63; float s = adab[(size_t)l * NMODW + n0 + n];
#pragma unroll
        for (int w = 0; w < 8; ++w) s += red[(w * 17 + r) * 64 + n];
        MOD[((size_t)l * 17 + r) * NMODW + n0 + n] = s; }
    __syncthreads();
}

__device__ __forceinline__ void shift_gemv(int wv__, char* lds, const float* modbase, int idx, const bf16* WT, float* S, int N, int vcu, int NGW) {
    int tid = TIDX(); asm volatile("" : "+v"(tid));
    const int lane = tid & 63, gw = vcu * 8 + __builtin_amdgcn_readfirstlane(tid >> 6);
    float* sh = (float*)lds;
    { float t[34];
#pragma unroll
      for (int j = 0; j < 34; ++j) { const int i = tid + 512 * j; t[j] = modbase[(size_t)(i >> 10) * NMODW + idx * DM + (i & 1023)]; }
#pragma unroll
      for (int j = 0; j < 34; ++j) sh[tid + 512 * j] = t[j]; }
    __syncthreads();
    v4u r0 = {0u, 0u, 0u, 0u}, r1 = {0u, 0u, 0u, 0u};
    if (gw < N) { const bf16* wrow = WT + (size_t)gw * DM + 8 * lane; r0 = *(const v4u*)wrow; r1 = *(const v4u*)(wrow + 512); }
    for (int p = gw; p < N; p += NGW) {
        float w[16];
        w[0] = __uint_as_float(r0.x << 16); w[1] = __uint_as_float(r0.x & 0xffff0000u); w[2] = __uint_as_float(r0.y << 16); w[3] = __uint_as_float(r0.y & 0xffff0000u);
        w[4] = __uint_as_float(r0.z << 16); w[5] = __uint_as_float(r0.z & 0xffff0000u); w[6] = __uint_as_float(r0.w << 16); w[7] = __uint_as_float(r0.w & 0xffff0000u);
        w[8] = __uint_as_float(r1.x << 16); w[9] = __uint_as_float(r1.x & 0xffff0000u); w[10] = __uint_as_float(r1.y << 16); w[11] = __uint_as_float(r1.y & 0xffff0000u);
        w[12] = __uint_as_float(r1.z << 16); w[13] = __uint_as_float(r1.z & 0xffff0000u); w[14] = __uint_as_float(r1.w << 16); w[15] = __uint_as_float(r1.w & 0xffff0000u);
        if (p + NGW < N) { const bf16* wn = WT + (size_t)(p + NGW) * DM + 8 * lane; r0 = *(const v4u*)wn; r1 = *(const v4u*)(wn + 512); }
#pragma unroll 1
        for (int b = 0; b < 17; ++b) { const float* s = sh + b * 1024 + 8 * lane; float a = 0.f;
#pragma unroll
            for (int i = 0; i < 8; ++i) a += w[i] * s[i] + w[8 + i] * s[512 + i];
            a = wave_sum(a);
            if (lane == 0) S[(size_t)b * N + p] = a; }
    }
    __syncthreads();
}

struct Args { const float* in[21]; float* out; unsigned char* ws; int ph_lo, ph_hi, coop, pad; };
constexpr int NPHASE = 13;

__global__ void __launch_bounds__(512, 2) mega_fwd(Args args) {
    extern __shared__ __attribute__((aligned(16))) unsigned char lds[];
    cg::grid_group grid = cg::this_grid();
    constexpr int G = 256; const int bx = blockIdx.x & 255;
    const int vcu = (bx % 8) * (G / 8) + bx / 8;
    const int NGW = G * 8;
    unsigned char* ws = args.ws;
    const float* x_in = args.in[0]; const float* c_in = args.in[1]; const float* ctx_in = args.in[2]; const float* cctx_in = args.in[3];
    const float* norm1_w = args.in[4]; const float* norm2_w = args.in[5]; const float* ada_w = args.in[6]; const float* ada_b = args.in[7];
    const float* w_in = args.in[8]; const float* ret_ld = args.in[9]; const float* ret_gn = args.in[10]; const float* dlam = args.in[11];
    const float* diff_gn = args.in[12]; const float* conv_w = args.in[13]; const float* conv_b = args.in[14]; const float* conv_lnw = args.in[15];
    const float* conv_lnb = args.in[16]; const float* w_out = args.in[17]; const float* mlp_w1 = args.in[18]; const float* mlp_w2 = args.in[19];
    const float* final_w = args.in[20];
    float* out = args.out;
    bf16* WinT = (bf16*)(ws + WS_WIN); bf16* WoutT = (bf16*)(ws + WS_WOUT); bf16* W1T = (bf16*)(ws + WS_W1); bf16* W2T = (bf16*)(ws + WS_W2);
    float* MOD = (float*)(ws + WS_MOD); float* SCAL = (float*)(ws + WS_SCAL); float* CTXRES = (float*)(ws + WS_CTXRES);
    float* SCR = (float*)(ws + WS_SCR) + (size_t)bx * (256 * 128);
    float* RSQ = (float*)(ws + WS_RSQ); float* S_UP = (float*)(ws + WS_SB); float* S_IN1 = (float*)(ws + WS_SB + MiB);
    bf16* XN = (bf16*)(ws + WS_XN); bf16* P = (bf16*)(ws + WS_P); bf16* MIX = (bf16*)(ws + WS_MIX); bf16* H = (bf16*)(ws + WS_H);
    volatile LAS unsigned* MISC = (volatile LAS unsigned*)((LAS unsigned char*)lds + 147456 + 64);
    const int wv__ = __builtin_amdgcn_readfirstlane(threadIdx.x >> 6);
    if (threadIdx.x < 4) MISC[threadIdx.x] = 0u;
    __syncthreads();
    XcdBarrier xbar; xbar.bar = (unsigned*)(ws + WS_CTL); xbar.x = 0; xbar.st = nullptr;
    xbar = xcd_barrier_post(wv__, (unsigned*)(ws + WS_CTL), MISC);
    if (args.coop == 2) grid.sync();
#define IN(k) true
#define SEAM(k) do { { { XcdBarrier xb_ = xbar; asm volatile("" : "+s"(xb_.bar), "+s"(xb_.x)); xcd_barrier(wv__, xb_); } } } while (0)

    if (IN(0)) {
        int tid = TIDX(); asm volatile("" : "+v"(tid)); const int lane = tid & 63, wave = __builtin_amdgcn_readfirstlane(tid >> 6), gw = vcu * 8 + wave;
        if (vcu < 192) mod_unit(wv__, (char*)lds, c_in, cctx_in, ada_w, ada_b, MOD, vcu / 96, vcu % 96);
        if (vcu == 255 && wave == 0) {
            for (int l = 0; l < 2; ++l) { const float* d = dlam + l * 256;
                const float sa = wave_sum(d[lane] * d[64 + lane]), sb = wave_sum(d[128 + lane] * d[192 + lane]);
                const float lam_init = (l == 0) ? 0.2f : (0.8f - 0.6f * 0.7408182206817179f);
                if (lane == 0) { SCAL[2 * l] = __expf(sa) - __expf(sb) + lam_init; SCAL[2 * l + 1] = lam_init; } }
        }
        __syncthreads();
        LAS float* scr = (LAS float*)((LAS unsigned char*)lds + wave * 16384);
        constexpr int I_IN = 16 * 96, I_OUT = 16 * 32, I_1 = 16 * 128, I_2 = 64 * 32, I_L = I_IN + I_OUT + I_1 + I_2;
        for (int it = gw; it < 2 * I_L; it += NGW) {
            const int l = it / I_L; int r = it % I_L;
            if (r < I_IN) { p0_transpose_item<true>(w_in + (size_t)l * DM * INW, DM, INW, WinT + (size_t)l * INW * DM, scr, r, lane); continue; } r -= I_IN;
            if (r < I_OUT) { p0_transpose_item<false>(w_out + (size_t)l * DM * DM, DM, DM, WoutT + (size_t)l * DM * DM, scr, r, lane); continue; } r -= I_OUT;
            if (r < I_1) { p0_transpose_item<false>(mlp_w1 + (size_t)l * DM * DFF, DM, DFF, W1T + (size_t)l * DFF * DM, scr, r, lane); continue; } r -= I_1;
            p0_transpose_item<false>(mlp_w2 + (size_t)l * DFF * DM, DFF, DM, W2T + (size_t)l * DM * DFF, scr, r, lane);
        }
        __syncthreads();
    }
    SEAM(0);
    if (IN(1)) {
        norm_mod_rows(wv__, x_in, ctx_in, norm1_w, MOD, 0, 1, XN, MTOT, vcu, NGW);
        shift_gemv(wv__, (char*)lds, MOD, 3, W1T, S_UP, DFF, vcu, NGW);
        shift_gemv(wv__, (char*)lds, MOD + (size_t)17 * NMODW, 3, W1T + (size_t)DFF * DM, S_UP + 17 * DFF, DFF, vcu, NGW);
        shift_gemv(wv__, (char*)lds, MOD + (size_t)17 * NMODW, 0, WinT + (size_t)INW * DM, S_IN1, INW, vcu, NGW);
    }
    SEAM(1);
#pragma unroll 1
    for (int l_ = 0; l_ < 2; ++l_) {
        int l = l_; asm volatile("" : "+s"(l));
        const int pb = 2 + 5 * l; const bool last = (l == 1);
        const float* modl = MOD + (size_t)l * 17 * NMODW;
        if (IN(pb)) {
            pg8::Gemm g{XN, WinT + (size_t)l * INW * DM, MTOT, INW, DM}; pg8::StaticOrder S; S.init(MTOT, INW, G, bx);
            if (l == 0) { EpiIn<false> E{P, nullptr, nullptr}; pg8::gemm_phase<EpiIn<false>, pg8::StaticOrder, true, true>(wv__, (LAS unsigned char*)lds, g, S, E); }
            else { EpiIn<true> E{P, RSQ + MTOT, S_IN1}; pg8::gemm_phase<EpiIn<true>, pg8::StaticOrder, true, true>(wv__, (LAS unsigned char*)lds, g, S, E); }
        }
        SEAM(pb);
        if (IN(pb + 1)) {
            const float lam = rfl_f(SCAL[2 * l]), lam_init = rfl_f(SCAL[2 * l + 1]);
            for (int i = 0; i < 2; ++i) {
                const int unit = i * 256 + vcu, bh = unit >> 3, qb = unit & 7, b = bh >> 2, h = bh & 3;
                att::diff_unit(wv__, (char*)lds, P, MIX, SCR, diff_gn + l * 512, lam, lam_init, (long)b * SEQ + qb * 256, (long)b * SEQ, 32, (long)NLAT + b * CTXL, 4, h);
            }
            for (int i = 0; i < 2; ++i) {
                const int unit = i * 256 + vcu, bh = unit >> 3, qb = unit & 7, b = bh >> 2, h = bh & 3;
                const float lf = rfl_f(-__expf(ret_ld[l * 8 + h]) * 1.4426950408889634f), lb = rfl_f(-__expf(ret_ld[l * 8 + 4 + h]) * 1.4426950408889634f);
                att::ret_unit_state(wv__, (char*)lds, P, MIX, ret_gn + l * 256, lf, lb, b, qb, h);
            }
            if (!last) {
                if (vcu < 64) { const int b = vcu >> 2, h = vcu & 3; const long cr = (long)NLAT + b * CTXL;
                    att::diff_unit(wv__, (char*)lds, P, MIX, SCR, diff_gn + l * 512, lam, lam_init, cr, cr, 4, cr, 0, h); }
                else if (vcu < 128) { const int b = (vcu - 64) >> 2, h = vcu & 3; const long cr = (long)NLAT + b * CTXL;
                    const float lf = rfl_f(-__expf(ret_ld[l * 8 + h]) * 1.4426950408889634f), lb = rfl_f(-__expf(ret_ld[l * 8 + 4 + h]) * 1.4426950408889634f);
                    att::ret_unit(wv__, (char*)lds, P, MIX, ret_gn + l * 256, lf, lb, cr, 0, cr, 4, cr, 0, h); }
            }
            const int nconv = last ? 512 : 576, cstep = last ? 256 : 192, cfirst = last ? 255 - vcu : vcu - 64;
            if (cfirst >= 0) for (int cu = cfirst; cu < nconv; cu += cstep) {
                long seqrow; int L, t0;
                if (cu < 512) { seqrow = (long)(cu >> 5) * SEQ; L = SEQ; t0 = (cu & 31) * 64; } else { const int c2 = cu - 512; seqrow = (long)NLAT + (c2 >> 2) * CTXL; L = CTXL; t0 = (c2 & 3) * 64; }
                conv_unit(wv__, (char*)lds, P, MIX, conv_w + l * 31 * 256, conv_b + l * 256, conv_lnw + l * 256, conv_lnb + l * 256, seqrow, L, t0);
            }
        }
        SEAM(pb + 1);
        if (IN(pb + 2)) {
            const int Mo = last ? NLAT : MTOT;
            pg8::Gemm g{MIX, WoutT + (size_t)l * DM * DM, Mo, DM, DM}; pg8::StaticOrder S; S.init(Mo, DM, G, bx);
            EpiRes E{l == 0 ? x_in : out, l == 0 ? ctx_in : CTXRES, out, CTXRES, modl, 2, XN, norm2_w + l * DM, modl, 4, RSQ + (size_t)(2 * l) * MTOT, nullptr, nullptr};
            pg8::gemm_phase<EpiRes, pg8::StaticOrder, true, true>(wv__, (LAS unsigned char*)lds, g, S, E);
        }
        SEAM(pb + 2);
        if (IN(pb + 3)) {
            const int Mo = last ? NLAT : MTOT;
            pg8::Gemm g{XN, W1T + (size_t)l * DFF * DM, Mo, DFF, DM}; pg8::StaticOrder S; S.init(Mo, DFF, G, bx);
            EpiUp E{H, RSQ + (size_t)(2 * l) * MTOT, S_UP + (size_t)l * 17 * DFF};
            pg8::gemm_phase<EpiUp, pg8::StaticOrder, true, true>(wv__, (LAS unsigned char*)lds, g, S, E);
        }
        SEAM(pb + 3);
        {
            float* part0 = (float*)(ws + WS_SCR); float* part1 = (float*)(ws + WS_PART2);
            if (last) {
                pg8::Gemm g{H, W2T + (size_t)l * DM * DFF, NLAT, DM, DFF}; pg8::StaticOrder S; S.init(NLAT, DM, G, bx);
                EpiRes E{out, CTXRES, out, CTXRES, modl, 5, (bf16*)nullptr, norm1_w + DM, MOD + (size_t)17 * NMODW, 1, RSQ + MTOT, part0, part1};
                pg8::gemm_phase<EpiRes, pg8::StaticOrder, true, true>(wv__, (LAS unsigned char*)lds, g, S, E);
            } else {
                pg8::Gemm g{H, W2T + (size_t)l * DM * DFF, MTOT, DM, DFF}; DownL0Order S; S.init(G, bx);
                EpiRes E{out, CTXRES, out, CTXRES, modl, 5, XN, norm1_w + DM, MOD + (size_t)17 * NMODW, 1, RSQ + MTOT, part0, part1};
                pg8::gemm_phase<EpiRes, DownL0Order, true, true>(wv__, (LAS unsigned char*)lds, g, S, E);
                SEAM(pb + 4);
                ctx_combine(wv__, CTXRES, part0, part1, modl + (size_t)16 * NMODW + 5 * DM, norm1_w + DM, MOD + (size_t)17 * NMODW + (size_t)16 * NMODW + 1 * DM, XN + (size_t)NLAT * DM, RSQ + MTOT + NLAT, vcu, NGW);
            }
        }
        SEAM(pb + 4);
    }
    if (IN(12)) final_norm_rows(wv__, out, final_w, vcu, NGW);
#undef IN
#undef SEAM
}

#ifndef MK_SPLIT
#define MK_SPLIT 0
#endif
extern "C" void kernel_launch(void* const* d_in, const int* in_sizes, int n_in, void* d_out, int out_size, void* d_ws, size_t ws_size, hipStream_t stream) {
    static int grid = 0;
    if (grid == 0) {
        if (n_in != 21 || in_sizes[0] != NLAT * DM || out_size != NLAT * DM || ws_size < WS_END) {
            fprintf(stderr, "kernel_launch: unexpected shapes: n_in %d in0 %d out %d ws %zu (need %zu)\n", n_in, n_in > 0 ? in_sizes[0] : -1, out_size, ws_size, (size_t)WS_END); grid = -1; return; }
        int dev = 0, cus = 0, per_cu = 0;
        (void)hipGetDevice(&dev); (void)hipDeviceGetAttribute(&cus, hipDeviceAttributeMultiprocessorCount, dev);
        if (hipFuncSetAttribute((const void*)mega_fwd, hipFuncAttributeMaxDynamicSharedMemorySize, LDS_BYTES) != hipSuccess) { fprintf(stderr, "kernel_launch: hipFuncSetAttribute failed\n"); grid = -1; return; }
        (void)hipOccupancyMaxActiveBlocksPerMultiprocessor(&per_cu, (const void*)mega_fwd, 512, LDS_BYTES);
        (void)hipGetLastError();
        fprintf(stderr, "kernel_launch: cus %d per_cu %d\n", cus, per_cu);
        if (cus < 256 || per_cu < 1) fprintf(stderr, "kernel_launch: needs 256 co-resident workgroups (cus %d, per_cu %d)\n", cus, per_cu);
        grid = 256;
    }
    if (grid < 0) return;
    if (hipMemsetAsync((char*)d_ws + WS_CTL, 0, CTL_ZERO_BYTES, stream) != hipSuccess) { fprintf(stderr, "kernel_launch: memset failed\n"); return; }
    Args a{};
    for (int i = 0; i < 21; ++i) a.in[i] = (const float*)d_in[i];
    a.out = (float*)d_out; a.ws = (unsigned char*)d_ws; a.pad = 0;
#if MK_SPLIT
    for (int p = 0; p < NPHASE; ++p) { a.ph_lo = p; a.ph_hi = p + 1; a.coop = 0; hipLaunchKernelGGL(mega_fwd, dim3(grid), dim3(512), LDS_BYTES, stream, a); }
#else
    a.ph_lo = 0; a.ph_hi = NPHASE; a.coop = 1;
    void* kargs[] = {&a};
    const hipError_t e = hipLaunchCooperativeKernel((const void*)mega_fwd, dim3(grid), dim3(512), kargs, LDS_BYTES, stream);
    if (e != hipSuccess) fprintf(stderr, "kernel_launch: cooperative launch failed: %s (grid %d)\n", hipGetErrorString(e), grid);
#endif
}
```
